# Optimizing an MI355X kernel written in HIP

```python
import math
import jax, jax.numpy as jnp
from jax import lax
import numpy as np

D_MODEL = 2048
BATCH = 2
SEQ = 4096
DEPTH = 2

D_MIX = D_MODEL
MLA_HEADS = 6
QK_NOPE = 128
QK_ROPE = 64
QK_HEAD = QK_NOPE + QK_ROPE
V_HEAD = 128
Q_LORA = 512
KV_LORA = 256
MLA_WIDTH = MLA_HEADS * V_HEAD
ROPE_THETA = 10000.0
Q_BLOCK = 128
CONV_WIDTH = 512
CONV_K = 31
SSD_HEADS = 12
SSD_HEAD_DIM = 64
SSD_WIDTH = SSD_HEADS * SSD_HEAD_DIM
SSD_GROUPS = 2
SSD_STATE = 128
SSD_CONV_K = 4
SSD_CHUNK = 128
SSD_XBC = SSD_WIDTH + 2 * SSD_GROUPS * SSD_STATE

NORM_EPS = 1e-6
LN_EPS = 1e-5

IN_SPLITS = (Q_LORA, KV_LORA, QK_ROPE, MLA_WIDTH,
             2 * CONV_WIDTH, CONV_WIDTH,
             SSD_WIDTH, SSD_XBC, SSD_HEADS)
D_IN_PROJ = sum(IN_SPLITS)

kernel_name = 'hybrid_mla_conformer_ssd_parallel'


def rms_norm(x, g, eps=NORM_EPS):
    xf = x.astype(jnp.float32)
    y = xf * lax.rsqrt(jnp.mean(xf * xf, axis=-1, keepdims=True) + eps)
    return (y * g.astype(jnp.float32)).astype(x.dtype)


def layer_norm(x, g, b, eps=LN_EPS):
    xf = x.astype(jnp.float32)
    mu = jnp.mean(xf, axis=-1, keepdims=True)
    var = jnp.mean(jnp.square(xf - mu), axis=-1, keepdims=True)
    y = (xf - mu) * lax.rsqrt(var + eps)
    return (y * g.astype(jnp.float32) + b.astype(jnp.float32)).astype(x.dtype)


def causal_depthwise_conv(x, w, b):
    k = w.shape[0]
    y = lax.conv_general_dilated(
        x, w[:, None, :].astype(x.dtype), window_strides=(1,), padding=[(k - 1, 0)],
        dimension_numbers=('NWC', 'WIO', 'NWC'), feature_group_count=x.shape[-1])
    return y + b.astype(x.dtype)


def apply_rope(x, pos):
    half = x.shape[-1] // 2
    inv_freq = ROPE_THETA ** (-jnp.arange(half, dtype=jnp.float32) / half)
    ang = pos.astype(jnp.float32)[:, None] * inv_freq[None, :]
    cos = jnp.cos(ang)[None, :, None, :]
    sin = jnp.sin(ang)[None, :, None, :]
    xf = x.astype(jnp.float32)
    x1, x2 = xf[..., :half], xf[..., half:]
    return jnp.concatenate([x1 * cos - x2 * sin, x2 * cos + x1 * sin], axis=-1).astype(x.dtype)


def blocked_causal_attention(q, k, v):
    bsz, s, h, dqk = q.shape
    dv = v.shape[-1]
    nb = s // Q_BLOCK
    scale = 1.0 / math.sqrt(dqk)
    qb = q.reshape(bsz, nb, Q_BLOCK, h, dqk).transpose(1, 0, 2, 3, 4)
    kpos = jnp.arange(s)

    def one_block(args):
        qi, i = args
        sc = jnp.einsum('bqhd,bkhd->bhqk', qi, k, preferred_element_type=jnp.float32) * scale
        qpos = i * Q_BLOCK + jnp.arange(Q_BLOCK)
        mask = kpos[None, :] <= qpos[:, None]
        sc = jnp.where(mask[None, None], sc, -jnp.inf)
        p = jax.nn.softmax(sc, axis=-1).astype(v.dtype)
        return jnp.einsum('bhqk,bkhd->bqhd', p, v)

    o = lax.map(one_block, (qb, jnp.arange(nb)))
    return o.transpose(1, 0, 2, 3, 4).reshape(bsz, s, h * dv)


def mla_mixer(c_q, c_kv, k_pe, q_a_norm, w_q_b, kv_a_norm, w_kv_b, q_norm, k_norm):
    bsz, s, _ = c_q.shape
    q = (rms_norm(c_q, q_a_norm) @ w_q_b).reshape(bsz, s, MLA_HEADS, QK_HEAD)
    kv = (rms_norm(c_kv, kv_a_norm) @ w_kv_b).reshape(bsz, s, MLA_HEADS, QK_NOPE + V_HEAD)
    k_nope, v = kv[..., :QK_NOPE], kv[..., QK_NOPE:]
    k_pe_h = jnp.broadcast_to(k_pe[:, :, None, :], (bsz, s, MLA_HEADS, QK_ROPE))
    k = jnp.concatenate([k_nope, k_pe_h], axis=-1)
    q = rms_norm(q, q_norm)
    k = rms_norm(k, k_norm)
    pos = jnp.arange(s)
    q = jnp.concatenate([q[..., :QK_NOPE], apply_rope(q[..., QK_NOPE:], pos)], axis=-1)
    k = jnp.concatenate([k[..., :QK_NOPE], apply_rope(k[..., QK_NOPE:], pos)], axis=-1)
    return blocked_causal_attention(q, k, v)


def conformer_conv_mixer(u, w_dw, b_dw, ln_g, ln_b, w_pw):
    a, g = u[..., :CONV_WIDTH], u[..., CONV_WIDTH:]
    h = a * jax.nn.sigmoid(g)
    h = causal_depthwise_conv(h, w_dw, b_dw)
    h = jax.nn.silu(layer_norm(h, ln_g, ln_b))
    return h @ w_pw


def ssd_chunked(x, dt, a_neg, bm, cm):
    bsz, s, h, p = x.shape
    g, n = bm.shape[2], bm.shape[3]
    r = h // g
    l = SSD_CHUNK
    c = s // l
    xf = x.astype(jnp.float32).reshape(bsz, c, l, g, r, p)
    dtc = dt.reshape(bsz, c, l, g, r)
    bc = bm.astype(jnp.float32).reshape(bsz, c, l, g, n)
    cc = cm.astype(jnp.float32).reshape(bsz, c, l, g, n)
    xdt = xf * dtc[..., None]
    a_cs = jnp.cumsum(dtc * a_neg.reshape(g, r), axis=2)
    seg = a_cs[:, :, :, None] - a_cs[:, :, None, :]
    causal = jnp.tril(jnp.ones((l, l), dtype=bool))
    decay = jnp.exp(jnp.where(causal[None, None, :, :, None, None], seg, -jnp.inf))
    cb = jnp.einsum('bclgn,bcsgn->bclsg', cc, bc)
    y_diag = jnp.einsum('bclsg,bclsgr,bcsgrp->bclgrp', cb, decay, xdt)
    decay_to_end = jnp.exp(a_cs[:, :, -1:] - a_cs)
    states = jnp.einsum('bclgn,bclgr,bclgrp->bcgrpn', bc, decay_to_end, xdt)
    chunk_decay = jnp.exp(a_cs[:, :, -1])

    def step(hstate, inp):
        st, dec = inp
        return hstate * dec[..., None, None] + st, hstate

    h0 = jnp.zeros((bsz, g, r, p, n), jnp.float32)
    _, prev = lax.scan(step, h0, (states.transpose(1, 0, 2, 3, 4, 5), chunk_decay.transpose(1, 0, 2, 3)))
    prev = prev.transpose(1, 0, 2, 3, 4, 5)
    y_off = jnp.einsum('bclgn,bcgrpn,bclgr->bclgrp', cc, prev, jnp.exp(a_cs))
    return (y_diag + y_off).reshape(bsz, s, h, p)


def ssd_mixer(z, xbc, dt_raw, conv_w, conv_b, dt_bias, a_log, d_skip, norm_g):
    bsz, s, _ = z.shape
    xbc = jax.nn.silu(causal_depthwise_conv(xbc, conv_w, conv_b))
    xs = xbc[..., :SSD_WIDTH].reshape(bsz, s, SSD_HEADS, SSD_HEAD_DIM)
    bm = xbc[..., SSD_WIDTH:SSD_WIDTH + SSD_GROUPS * SSD_STATE].reshape(bsz, s, SSD_GROUPS, SSD_STATE)
    cm = xbc[..., SSD_WIDTH + SSD_GROUPS * SSD_STATE:].reshape(bsz, s, SSD_GROUPS, SSD_STATE)
    dt = jax.nn.softplus(dt_raw.astype(jnp.float32) + dt_bias.astype(jnp.float32))
    a_neg = -jnp.exp(a_log.astype(jnp.float32))
    y = ssd_chunked(xs, dt, a_neg, bm, cm)
    y = y + d_skip.astype(jnp.float32)[:, None] * xs.astype(jnp.float32)
    y = y.reshape(bsz, s, SSD_WIDTH).astype(z.dtype)
    return rms_norm(y * jax.nn.silu(z), norm_g)


def hybrid_layer(x, norm_g, w_in, q_a_norm, w_q_b, kv_a_norm, w_kv_b, q_norm, k_norm,
                 conv_dw_w, conv_dw_b, conv_ln_g, conv_ln_b, conv_pw_w,
                 ssd_conv_w, ssd_conv_b, ssd_dt_bias, ssd_A_log, ssd_D, ssd_norm_g, w_out):
    h = rms_norm(x, norm_g)
    u = h @ w_in
    offs = np.cumsum(IN_SPLITS)[:-1].tolist()
    c_q, c_kv, k_pe, g_mla, u_conv, g_conv, z, xbc, dt_raw = jnp.split(u, offs, axis=-1)
    o_mla = mla_mixer(c_q, c_kv, k_pe, q_a_norm, w_q_b, kv_a_norm, w_kv_b, q_norm, k_norm) * jax.nn.silu(g_mla)
    o_conv = conformer_conv_mixer(u_conv, conv_dw_w, conv_dw_b, conv_ln_g, conv_ln_b, conv_pw_w) * jax.nn.silu(g_conv)
    o_ssd = ssd_mixer(z, xbc, dt_raw, ssd_conv_w, ssd_conv_b, ssd_dt_bias, ssd_A_log, ssd_D, ssd_norm_g)
    y = jnp.concatenate([o_mla, o_conv, o_ssd], axis=-1) @ w_out
    return x + y


def setup_inputs(seed: int = 0) -> dict:
    key = jax.random.key(seed)
    ks = jax.random.split(key, 24)
    f32 = jnp.float32

    def nrm(k, shape, fan_in):
        return jax.random.normal(k, shape, f32) * (fan_in ** -0.5)

    def gain(k, shape):
        return 1.0 + 0.02 * jax.random.normal(k, shape, f32)

    def small(k, shape):
        return 0.02 * jax.random.normal(k, shape, f32)

    dt0 = jnp.exp(jax.random.uniform(ks[17], (DEPTH, SSD_HEADS), f32, math.log(1e-3), math.log(1e-1)))
    return {
        'x': jax.random.normal(ks[0], (BATCH, SEQ, D_MODEL), f32),
        'norm_g': gain(ks[1], (DEPTH, D_MODEL)),
        'w_in': nrm(ks[2], (DEPTH, D_MODEL, D_IN_PROJ), D_MODEL),
        'q_a_norm': gain(ks[3], (DEPTH, Q_LORA)),
        'w_q_b': nrm(ks[4], (DEPTH, Q_LORA, MLA_HEADS * QK_HEAD), Q_LORA),
        'kv_a_norm': gain(ks[5], (DEPTH, KV_LORA)),
        'w_kv_b': nrm(ks[6], (DEPTH, KV_LORA, MLA_HEADS * (QK_NOPE + V_HEAD)), KV_LORA),
        'q_norm': gain(ks[7], (DEPTH, QK_HEAD)),
        'k_norm': gain(ks[8], (DEPTH, QK_HEAD)),
        'conv_dw_w': nrm(ks[9], (DEPTH, CONV_K, CONV_WIDTH), CONV_K),
        'conv_dw_b': small(ks[10], (DEPTH, CONV_WIDTH)),
        'conv_ln_g': gain(ks[11], (DEPTH, CONV_WIDTH)),
        'conv_ln_b': small(ks[12], (DEPTH, CONV_WIDTH)),
        'conv_pw_w': nrm(ks[13], (DEPTH, CONV_WIDTH, CONV_WIDTH), CONV_WIDTH),
        'ssd_conv_w': nrm(ks[14], (DEPTH, SSD_CONV_K, SSD_XBC), SSD_CONV_K),
        'ssd_conv_b': small(ks[15], (DEPTH, SSD_XBC)),
        'ssd_dt_bias': dt0 + jnp.log(-jnp.expm1(-dt0)),
        'ssd_A_log': jnp.log(jax.random.uniform(ks[18], (DEPTH, SSD_HEADS), f32, 1.0, 16.0)),
        'ssd_D': gain(ks[19], (DEPTH, SSD_HEADS)),
        'ssd_norm_g': gain(ks[20], (DEPTH, SSD_WIDTH)),
        'w_out': nrm(ks[21], (DEPTH, D_MIX, D_MODEL), D_MIX),
    }


def reference(x, norm_g, w_in, q_a_norm, w_q_b, kv_a_norm, w_kv_b, q_norm, k_norm,
              conv_dw_w, conv_dw_b, conv_ln_g, conv_ln_b, conv_pw_w,
              ssd_conv_w, ssd_conv_b, ssd_dt_bias, ssd_A_log, ssd_D, ssd_norm_g, w_out):
    for i in range(DEPTH):
        x = hybrid_layer(x, norm_g[i], w_in[i], q_a_norm[i], w_q_b[i], kv_a_norm[i], w_kv_b[i],
                         q_norm[i], k_norm[i], conv_dw_w[i], conv_dw_b[i], conv_ln_g[i],
                         conv_ln_b[i], conv_pw_w[i], ssd_conv_w[i], ssd_conv_b[i],
                         ssd_dt_bias[i], ssd_A_log[i], ssd_D[i], ssd_norm_g[i], w_out[i])
    return x
```

```cpp
#include <hip/hip_runtime.h>
#include <hip/hip_cooperative_groups.h>
#include <cstdio>
#include <cstdint>
namespace cg = cooperative_groups;
#define DI __device__ __forceinline__
typedef unsigned short bf16_t;
typedef short bf16x8 __attribute__((ext_vector_type(8)));
typedef short bf16x4 __attribute__((ext_vector_type(4)));
typedef float f32x4 __attribute__((ext_vector_type(4)));
typedef unsigned u32x4 __attribute__((ext_vector_type(4)));
typedef unsigned u32x2 __attribute__((ext_vector_type(2)));
constexpr int T = 8192, SEQ = 4096, DM = 2048, NIN = 5196, LDU = 5248;
constexpr int LDX = 2112, LDQW = 576, LDKVW = 320, LDPW = 576, LDHC = 576, LDVT = 4160;
constexpr int NT = 256;
constexpr int U_CQ = 0, U_CKV = 512, U_KPE = 768, U_GMLA = 832, U_CA = 1600, U_CG = 2112, U_GCONV = 2624, U_Z = 3136, Z_HEAD = 688, U_XBC = 3824, U_DT = 5104, U_ZT = 5120;
DI int win_src_col(int n) { return n < 3824 ? n : (n < 5116 ? n + 80 : (n < 5120 ? -1 : (n < 5200 ? n - 1296 : -1))); }
constexpr int MIX_SSD = 0, MIX_MLA = 768, MIX_CONV = 1536;
constexpr int SMEM_BYTES = 77824;
constexpr int GEMM_SM = 4 * 128 * 72 * 2;
constexpr size_t al256(size_t x) { return (x + 255) & ~(size_t)255; }
constexpr size_t WS_CTRL = 0;
constexpr size_t WS_BAR = 1024;
constexpr size_t WS_WIN = 16384;
constexpr size_t SZ_WIN = (size_t)LDU * LDX * 2;
constexpr size_t WS_WQ = WS_WIN + 2 * SZ_WIN;
constexpr size_t SZ_WQ = (size_t)1152 * LDQW * 2;
constexpr size_t WS_WKV = WS_WQ + 2 * SZ_WQ;
constexpr size_t SZ_WKV = (size_t)1536 * LDKVW * 2;
constexpr size_t WS_WPW = WS_WKV + 2 * SZ_WKV;
constexpr size_t SZ_WPW = (size_t)512 * LDPW * 2;
constexpr size_t WS_WOUT = WS_WPW + 2 * SZ_WPW;
constexpr size_t SZ_WOUT = (size_t)2048 * LDX * 2;
constexpr size_t WS_COS = WS_WOUT + 2 * SZ_WOUT;
constexpr size_t WS_SIN = WS_COS + (size_t)4096 * 32 * 4;
constexpr size_t WS_XBA = WS_SIN + (size_t)4096 * 32 * 4;
constexpr size_t WS_XBB = WS_XBA + (size_t)T * LDX * 2;
constexpr size_t WS_HC = WS_XBB + (size_t)T * 768 * 4;
constexpr size_t WS_U = WS_XBB + (size_t)T * LDX * 2;
constexpr size_t WS_QRAW = WS_U + (size_t)T * LDU * 2;
constexpr size_t WS_KN = WS_QRAW + (size_t)T * 1152 * 2;
constexpr size_t WS_VT = WS_KN + (size_t)T * 1152 * 2;
constexpr size_t WS_XBCC = WS_VT + (size_t)12 * 128 * LDVT * 2;
constexpr size_t WS_STATES = WS_XBCC + (size_t)T * 1280 * 2;
constexpr size_t WS_DTRAW = WS_STATES + (size_t)T * 768 * 4;
constexpr size_t WS_DT = WS_DTRAW + (size_t)T * 12 * 4;
constexpr size_t WS_ACS = WS_DT + (size_t)T * 12 * 4;
constexpr size_t WS_SSX = WS_ACS + (size_t)T * 12 * 4;
constexpr size_t WS_SSS = WS_SSX + (size_t)T * 4;
constexpr size_t WS_PO = WS_SSS + (size_t)T * 4;
constexpr size_t WS_PML = WS_PO + (size_t)384 * 128 * 128 * 2;
constexpr size_t WS_END = WS_PML + (size_t)384 * 128 * 2 * 4;
static_assert(WS_END <= 340000000ull, "workspace too large");
static_assert((size_t)T * 768 * 4 + (size_t)T * LDHC * 2 <= (size_t)T * LDX * 2, "ydiag + hc alias inside xbB");
struct P {
  const float* x; const float* norm_g; const float* w_in; const float* q_a_norm; const float* w_q_b; const float* kv_a_norm;
  const float* w_kv_b; const float* q_norm; const float* k_norm; const float* conv_dw_w; const float* conv_dw_b; const float* conv_ln_g;
  const float* conv_ln_b; const float* conv_pw_w; const float* ssd_conv_w; const float* ssd_conv_b; const float* ssd_dt_bias;
  const float* ssd_A_log; const float* ssd_D; const float* ssd_norm_g; const float* w_out;
  float* out; unsigned char* ws;
  int phase_lo, phase_hi, coop, pad;
};
DI int otid() { int t = threadIdx.x; asm volatile("" : "+v"(t)); return t; }
DI float bf2f(bf16_t h) { return __uint_as_float(((unsigned)h) << 16); }
typedef __bf16 hbf2 __attribute__((ext_vector_type(2)));
typedef float f32x2 __attribute__((ext_vector_type(2)));
DI unsigned pk2(float a, float b) { f32x2 v = {a, b}; hbf2 r = __builtin_convertvector(v, hbf2); return __builtin_bit_cast(unsigned, r); }
DI bf16_t f2bf(float x) { return (bf16_t)(pk2(x, 0.f) & 0xffffu); }
DI float lo2f(unsigned w) { return __uint_as_float(w << 16); }
DI float hi2f(unsigned w) { return __uint_as_float(w & 0xffff0000u); }
DI float sigmoidf_(float x) { return 1.f / (1.f + __expf(-x)); }
DI float siluf_(float x) { return x / (1.f + __expf(-x)); }
DI f32x4 mfma16(bf16x8 a, bf16x8 b, f32x4 c) { return __builtin_amdgcn_mfma_f32_16x16x32_bf16(a, b, c, 0, 0, 0); }
DI bf16x8 pack8(float a0, float a1, float a2, float a3, float a4, float a5, float a6, float a7) {
  u32x4 w; w.x = pk2(a0, a1); w.y = pk2(a2, a3); w.z = pk2(a4, a5); w.w = pk2(a6, a7); return __builtin_bit_cast(bf16x8, w);
}
DI void unpack8(u32x4 w, float* v) {
  v[0] = lo2f(w.x); v[1] = hi2f(w.x); v[2] = lo2f(w.y); v[3] = hi2f(w.y); v[4] = lo2f(w.z); v[5] = hi2f(w.z); v[6] = lo2f(w.w); v[7] = hi2f(w.w);
}

#define XB_TMO      128
#define XB_XCNT(j)  (256  + 64 * (j))
#define XB_XSUB(j)  (1280 + 64 * (j))
#define XB_XGEN(j)  (2304 + 64 * (j))
#define XB_TOP      3328
#define XB_TOPGEN   3392
#define XCD_BAR_WORDS 3456
#define XB_SPIN_CAP (1u << 20)
#define LAS __attribute__((address_space(3)))
DI unsigned xb_ld(unsigned* p) { return __hip_atomic_load(p, __ATOMIC_RELAXED, __HIP_MEMORY_SCOPE_AGENT); }
DI unsigned xb_add(unsigned* p, unsigned v) { return __hip_atomic_fetch_add(p, v, __ATOMIC_RELAXED, __HIP_MEMORY_SCOPE_AGENT); }
DI unsigned xb_xcc_id() { return (unsigned)__builtin_amdgcn_s_getreg((3 << 11) | 20) & 0xFu; }
#define XB_SPIN(cond, bar) do { unsigned _sp = 0; while (cond) { __builtin_amdgcn_s_sleep(1); \
    if ((++_sp & 255u) == 0u) { if (xb_ld(&(bar)[XB_TMO])) break; if (_sp > XB_SPIN_CAP) { atomicAdd(&(bar)[XB_TMO], 1u); break; } } } } while (0)
struct XcdBarrier { unsigned* bar; unsigned x; volatile LAS unsigned* st; };
DI XcdBarrier xcd_barrier_post(unsigned* bar, volatile LAS unsigned* st) {
  XcdBarrier b; b.bar = bar; b.x = xb_xcc_id(); b.st = st;
  if (threadIdx.x == 0) (void)xb_add(&bar[XB_XCNT(b.x)], 1u);
  return b;
}
DI void xcd_barrier_complete(unsigned* bar, unsigned x, unsigned& nloc, unsigned& nx) {
  const unsigned G = gridDim.x * gridDim.y * gridDim.z;
  unsigned sum, cnt, mine, sp = 0u;
  for (;;) {
    sum = 0u; cnt = 0u; mine = 0u;
#pragma unroll
    for (unsigned j = 0; j < 16; ++j) { const unsigned c = xb_ld(&bar[XB_XCNT(j)]); sum += c; cnt += (c > 0u) ? 1u : 0u; mine = (j == x) ? c : mine; }
    if (sum == G) break;
    __builtin_amdgcn_s_sleep(1);
    if ((++sp & 255u) == 0u) { if (xb_ld(&bar[XB_TMO])) break; if (sp > XB_SPIN_CAP) { atomicAdd(&bar[XB_TMO], 1u); break; } }
  }
  nloc = mine > 0u ? mine : 1u; nx = cnt > 0u ? cnt : 1u;
}
DI void xcd_barrier(const XcdBarrier& b) {
  asm volatile("s_waitcnt vmcnt(0)" ::: "memory");
  __syncthreads();
  if (threadIdx.x == 0) {
    unsigned* bar = b.bar;
    __builtin_amdgcn_s_waitcnt(0);
    unsigned nloc = b.st[0], nx = b.st[1];
    if (nloc == 0u) { xcd_barrier_complete(bar, b.x, nloc, nx); b.st[0] = nloc; b.st[1] = nx; }
    const unsigned old = xb_add(&bar[XB_XSUB(b.x)], 1u);
    const unsigned gen = old / nloc;
    if (old + 1u == (gen + 1u) * nloc) {
      __builtin_amdgcn_fence(__ATOMIC_RELEASE, "agent");
      asm volatile("s_waitcnt vmcnt(0)" ::: "memory");
      const unsigned og = xb_add(&bar[XB_TOP], 1u);
      const unsigned tg = og / nx;
      if (og + 1u == (tg + 1u) * nx) xb_add(&bar[XB_TOPGEN], 1u);
      else XB_SPIN(xb_ld(&bar[XB_TOPGEN]) == tg, bar);
      __builtin_amdgcn_fence(__ATOMIC_ACQUIRE, "agent");
      xb_add(&bar[XB_XGEN(b.x)], 1u);
      asm volatile("s_waitcnt vmcnt(0)" ::: "memory");
    } else {
      XB_SPIN(xb_ld(&bar[XB_XGEN(b.x)]) == gen, bar);
      __builtin_amdgcn_fence(__ATOMIC_ACQUIRE, "agent");
      asm volatile("s_waitcnt vmcnt(0)" ::: "memory");
    }
  }
  __syncthreads();
}

template <bool SCALE>
DI void gemm_tile(const bf16_t* A, long lda, const bf16_t* Bt, long ldb, int K, unsigned char* smem, f32x4 (&acc)[4][4], int ksplit, const float (&rscale)[4]) {
  const int tid = otid(), lane = tid & 63, wave = tid >> 6, wr = wave >> 1, wc = wave & 1, r = lane & 15, quad = lane >> 4;
  bf16_t* sA = (bf16_t*)smem;
  bf16_t* sB = (bf16_t*)smem + 2 * 128 * 64;
#pragma unroll
  for (int i = 0; i < 4; ++i)
#pragma unroll
    for (int j = 0; j < 4; ++j) acc[i][j] = (f32x4){0.f, 0.f, 0.f, 0.f};
  const int lrow = tid >> 3, lcc = ((tid & 7) ^ (lrow & 7)) * 8;
  const bf16_t* ga = A + (long)lrow * lda + lcc;
  const bf16_t* gb = Bt + (long)lrow * ldb + lcc;
  const int x0 = (quad ^ (r & 7)) * 8, x1 = ((quad ^ (r & 7)) ^ 4) * 8;
  const int nk = K >> 6;
#define G_DMA(bo, kt) { _Pragma("unroll") for (int i = 0; i < 4; ++i) {                                                                                   \
      __builtin_amdgcn_global_load_lds((const unsigned*)(ga + (long)(32 * i) * lda + (kt) * 64), (unsigned*)(sA + (bo) + i * 2048 + tid * 8), 16, 0, 0);    \
      __builtin_amdgcn_global_load_lds((const unsigned*)(gb + (long)(32 * i) * ldb + (kt) * 64), (unsigned*)(sB + (bo) + i * 2048 + tid * 8), 16, 0, 0); } }
#define G_COMPUTE(bo, kt)                                                                                   \
  {                                                                                                         \
    const bf16_t* cA = sA + (bo) + (wr * 64 + r) * 64;                                                      \
    const bf16_t* cB = sB + (bo) + (wc * 64 + r) * 64;                                                      \
    _Pragma("unroll") for (int ks = 0; ks < 2; ++ks) {                                                      \
      const int xo = ks ? x1 : x0;                                                                          \
      bf16x8 af[4], bfr[4];                                                                                 \
      _Pragma("unroll") for (int i = 0; i < 4; ++i) { af[i] = *(const bf16x8*)(cA + i * 16 * 64 + xo); bfr[i] = *(const bf16x8*)(cB + i * 16 * 64 + xo); } \
      _Pragma("unroll") for (int i = 0; i < 4; ++i)                                                         \
        _Pragma("unroll") for (int j = 0; j < 4; ++j) acc[i][j] = mfma16(bfr[j], af[i], acc[i][j]);         \
    }                                                                                                       \
    if (SCALE) { if ((kt) + 1 == ksplit) {                                                                  \
      _Pragma("unroll") for (int i = 0; i < 4; ++i)                                                         \
        _Pragma("unroll") for (int j = 0; j < 4; ++j) acc[i][j] *= rscale[i]; } }                           \
  }
  __syncthreads();
  G_DMA(0, 0)
  __syncthreads();
#pragma unroll 1
  for (int kt = 0; kt < nk; ++kt) {
    const int cur = (kt & 1) * 8192, nxt = cur ^ 8192;
    const int kl = (kt + 1 < nk) ? kt + 1 : nk - 1;
    G_DMA(nxt, kl)
    G_COMPUTE(cur, kt)
    __syncthreads();
  }
#define G_LOAD
#undef G_LOAD
#undef G_DMA
#undef G_COMPUTE
}

template <int W>
DI void rows_rstd(const bf16_t* base, long ld, float eps, float* rs) {
  const int tid = otid(), row = tid >> 1, half = tid & 1;
  const bf16_t* ptr = base + (long)row * ld + half * (W >> 1);
  u32x4 v[W / 16];
#pragma unroll
  for (int i = 0; i < W / 16; ++i) v[i] = *(const u32x4*)(ptr + i * 8);
  float ss = 0.f;
#pragma unroll
  for (int i = 0; i < W / 16; ++i) {
    float f[8]; unpack8(v[i], f);
#pragma unroll
    for (int e = 0; e < 8; ++e) ss += f[e] * f[e];
  }
  ss += __shfl_xor(ss, 1);
  if (!half) rs[row] = rsqrtf(ss / (float)W + eps);
}

struct TrArgs { const float* src; const float* gain; bf16_t* dst; int N, ksrc0, n0, ldd, kdst0, remap; };
DI void transpose_tile2(const TrArgs& a0, const TrArgs& a1, unsigned char* smem) {
  const int tid = otid();
  f32x4 v4[2][4]; float gn[2][4];
#pragma unroll
  for (int u = 0; u < 2; ++u) {
    const TrArgs& a = u ? a1 : a0;
#pragma unroll
    for (int i = 0; i < 4; ++i) {
      const int idx4 = tid + 256 * i, kk = idx4 >> 4, n = a.n0 + (idx4 & 15) * 4;
      const int sn = a.remap ? win_src_col(n) : (n < a.N ? n : -1);
      v4[u][i] = (sn >= 0) ? __builtin_nontemporal_load((const f32x4*)(a.src + (long)(a.ksrc0 + kk) * a.N + sn)) : (f32x4){0.f, 0.f, 0.f, 0.f};
      gn[u][i] = a.gain ? a.gain[kk] : 1.f;
    }
  }
  __syncthreads();
#pragma unroll
  for (int u = 0; u < 2; ++u) {
    float* t = (float*)smem + u * (64 * 65);
#pragma unroll
    for (int i = 0; i < 4; ++i) {
      const int idx4 = tid + 256 * i, kk = idx4 >> 4, nn = (idx4 & 15) * 4;
      t[kk * 65 + nn] = v4[u][i][0] * gn[u][i]; t[kk * 65 + nn + 1] = v4[u][i][1] * gn[u][i]; t[kk * 65 + nn + 2] = v4[u][i][2] * gn[u][i]; t[kk * 65 + nn + 3] = v4[u][i][3] * gn[u][i];
    }
  }
  __syncthreads();
  const int nn = tid >> 2, kc = (tid & 3) * 16;
#pragma unroll
  for (int u = 0; u < 2; ++u) {
    const TrArgs& a = u ? a1 : a0;
    const float* t = (const float*)smem + u * (64 * 65);
    float v[16];
#pragma unroll
    for (int j = 0; j < 16; ++j) v[j] = t[(kc + j) * 65 + nn];
    u32x4 w0, w1;
    w0.x = pk2(v[0], v[1]); w0.y = pk2(v[2], v[3]); w0.z = pk2(v[4], v[5]); w0.w = pk2(v[6], v[7]);
    w1.x = pk2(v[8], v[9]); w1.y = pk2(v[10], v[11]); w1.z = pk2(v[12], v[13]); w1.w = pk2(v[14], v[15]);
    bf16_t* d = a.dst + (long)(a.n0 + nn) * a.ldd + a.kdst0 + kc;
    *(u32x4*)d = w0; *(u32x4*)(d + 8) = w1;
  }
}

constexpr int T_WIN = 32 * 82, T_WQ = 8 * 18, T_WKV = 4 * 24, T_WPW = 8 * 8, T_WOUT = 32 * 32;
constexpr int TR_PER_L = T_WIN + T_WQ + T_WKV + T_WPW + T_WOUT;
DI TrArgs tr_decode(const P& p, int it) {
  unsigned char* ws = p.ws;
  const int L = it / TR_PER_L; int r = it % TR_PER_L;
  TrArgs a; a.remap = 0;
  if (r < T_WIN) {
    a.remap = 1;
    const int kt = r % 32, nt = r / 32;
    a.src = p.w_in + (size_t)L * 2048 * NIN; a.N = NIN; a.ksrc0 = kt * 64; a.n0 = nt * 64; a.gain = p.norm_g + L * 2048 + kt * 64; a.dst = (bf16_t*)(ws + WS_WIN + L * SZ_WIN); a.ldd = LDX; a.kdst0 = kt * 64;
  } else if ((r -= T_WIN) < T_WQ) {
    const int kt = r % 8, nt = r / 8;
    a.src = p.w_q_b + (size_t)L * 512 * 1152; a.N = 1152; a.ksrc0 = kt * 64; a.n0 = nt * 64; a.gain = p.q_a_norm + L * 512 + kt * 64; a.dst = (bf16_t*)(ws + WS_WQ + L * SZ_WQ); a.ldd = LDQW; a.kdst0 = kt * 64;
  } else if ((r -= T_WQ) < T_WKV) {
    const int kt = r % 4, nt = r / 4;
    a.src = p.w_kv_b + (size_t)L * 256 * 1536; a.N = 1536; a.ksrc0 = kt * 64; a.n0 = nt * 64; a.gain = p.kv_a_norm + L * 256 + kt * 64; a.dst = (bf16_t*)(ws + WS_WKV + L * SZ_WKV); a.ldd = LDKVW; a.kdst0 = kt * 64;
  } else if ((r -= T_WKV) < T_WPW) {
    const int kt = r % 8, nt = r / 8;
    a.src = p.conv_pw_w + (size_t)L * 512 * 512; a.N = 512; a.ksrc0 = kt * 64; a.n0 = nt * 64; a.gain = nullptr; a.dst = (bf16_t*)(ws + WS_WPW + L * SZ_WPW); a.ldd = LDPW; a.kdst0 = kt * 64;
  } else {
    r -= T_WPW;
    const int kt = r % 32, nt = r / 32, kd = kt * 64;
    a.src = p.w_out + (size_t)L * 2048 * 2048; a.N = 2048; a.ksrc0 = (kd < 768) ? kd + 1280 : kd - 768; a.n0 = nt * 64; a.gain = (kd < 768) ? p.ssd_norm_g + L * 768 + kd : nullptr;
    a.dst = (bf16_t*)(ws + WS_WOUT + L * SZ_WOUT); a.ldd = LDX; a.kdst0 = kd;
  }
  return a;
}

DI void phase0(const P& p, unsigned char* smem) {
  const int tid = otid();
  unsigned char* ws = p.ws;
  constexpr int N_TR = 2 * TR_PER_L, N_TR2 = N_TR / 2, N_X = T / 4, N_ROPE = 4096 * 32 / 256;
  static_assert(N_TR % 2 == 0, "pairs");
  for (int it = blockIdx.x; it < N_TR2 + N_X + N_ROPE; it += gridDim.x) {
    if (it < N_TR2) {
      const TrArgs a0 = tr_decode(p, 2 * it), a1 = tr_decode(p, 2 * it + 1);
      transpose_tile2(a0, a1, smem);
    } else if (it < N_TR2 + N_X) {
      const int row = (it - N_TR2) * 4 + (tid >> 6), lane = tid & 63;
      const float* xr = p.x + (size_t)row * 2048;
      bf16_t* xb = (bf16_t*)(ws + WS_XBA) + (size_t)row * LDX;
      float ss = 0.f;
#pragma unroll
      for (int i = 0; i < 8; ++i) {
        f32x4 v = __builtin_nontemporal_load((const f32x4*)(xr + lane * 4 + 256 * i));
        ss += v[0] * v[0] + v[1] * v[1] + v[2] * v[2] + v[3] * v[3];
        u32x2 w; w.x = pk2(v[0], v[1]); w.y = pk2(v[2], v[3]);
        *(u32x2*)(xb + lane * 4 + 256 * i) = w;
      }
#pragma unroll
      for (int o = 1; o < 64; o <<= 1) ss += __shfl_xor(ss, o);
      if (lane == 0) ((float*)(ws + WS_SSX))[row] = ss;
    } else {
      const int idx = (it - N_TR2 - N_X) * 256 + tid, s = idx >> 5, i = idx & 31;
      const float invf = (float)exp(-(double)i * (9.210340371976184 / 32.0));
      const float ang = (float)s * invf;
      double rev = (double)ang * 0.15915494309189535; rev -= floor(rev);
      ((float*)(ws + WS_COS))[idx] = __builtin_amdgcn_cosf((float)rev);
      ((float*)(ws + WS_SIN))[idx] = __builtin_amdgcn_sinf((float)rev);
    }
  }
}
DI void inproj_tile(const P& p, int L, int mt_, int nt_, unsigned char* smem) {
  unsigned char* ws = p.ws;
  const bf16_t* xb = (const bf16_t*)(ws + (L == 0 ? WS_XBA : WS_XBB));
  const bf16_t* W = (const bf16_t*)(ws + WS_WIN + L * SZ_WIN);
  bf16_t* U = (bf16_t*)(ws + WS_U);
  float* dtraw = (float*)(ws + WS_DTRAW);
  const float* ssx = (const float*)(ws + WS_SSX);
  const int tid = otid(), lane = tid & 63, wave = tid >> 6, wr = wave >> 1, wc = wave & 1, r = lane & 15, quad = lane >> 4;
  f32x4 acc[4][4]; const float dummy[4] = {1.f, 1.f, 1.f, 1.f};
  float rsv[4];
#pragma unroll
  for (int i = 0; i < 4; ++i) rsv[i] = rsqrtf(ssx[mt_ * 128 + wr * 64 + i * 16 + r] * (1.f / 2048.f) + 1e-6f);
  gemm_tile<false>(xb + (size_t)mt_ * 128 * LDX, LDX, W + (size_t)nt_ * 128 * LDX, LDX, 2048, smem, acc, 0, dummy);
#pragma unroll
  for (int i = 0; i < 4; ++i) {
    const int row = mt_ * 128 + wr * 64 + i * 16 + r;
    const float rs = rsv[i];
#pragma unroll
    for (int j = 0; j < 4; ++j) {
      const int col = nt_ * 128 + wc * 64 + j * 16 + quad * 4;
      f32x4 v = acc[i][j] * rs;
      if (col >= U_DT && col < U_DT + 12) { *(f32x4*)(dtraw + (size_t)row * 12 + (col - U_DT)) = v; }
      else { u32x2 w; w.x = pk2(v[0], v[1]); w.y = pk2(v[2], v[3]); *(u32x2*)(U + (size_t)row * LDU + col) = w; }
    }
  }
}
DI void phase1(const P& p, int L, unsigned char* smem) {
  constexpr int NTILE = 64 * 40;
  for (int t = blockIdx.x; t < NTILE; t += gridDim.x) {
    const int mg = t / (16 * 40), rr = t % (16 * 40), mt_ = mg * 16 + rr / 40, nt_ = rr % 40;
    inproj_tile(p, L, mt_, nt_, smem);
  }
}

DI void kv_item(const P& p, int L, int mt_, int j, unsigned char* smem) {
  unsigned char* ws = p.ws;
  const bf16_t* U = (const bf16_t*)(ws + WS_U);
  const bf16_t* W = (const bf16_t*)(ws + WS_WKV + L * SZ_WKV);
  const int tid = otid(), lane = tid & 63, wave = tid >> 6, wr = wave >> 1, wc = wave & 1, r = lane & 15, quad = lane >> 4;
  const int tok0 = mt_ * 128, h = j >> 1, part = j & 1, b = tok0 >> 12, s0 = tok0 & 4095;
  float* rs_s = (float*)(smem + GEMM_SM);
  float* red = rs_s + 128;
  float* pe_ss = red + 256;
  float* rk_s = pe_ss + 128;
  const bf16_t* ckv = U + (size_t)tok0 * LDU + U_CKV;
  __syncthreads();
  rows_rstd<256>(ckv, LDU, 1e-6f, rs_s);
  f32x4 acc[4][4]; const float dummy[4] = {1.f, 1.f, 1.f, 1.f};
  if (part == 0) {
    gemm_tile<false>(ckv, LDU, W + (size_t)(h * 256) * LDKVW, LDKVW, 256, smem, acc, 0, dummy);
#pragma unroll
    for (int i = 0; i < 4; ++i) {
      const int row = wr * 64 + i * 16 + r; const float rsv = rs_s[row]; float s = 0.f;
#pragma unroll
      for (int jj = 0; jj < 4; ++jj) { acc[i][jj] *= rsv; s += acc[i][jj][0] * acc[i][jj][0] + acc[i][jj][1] * acc[i][jj][1] + acc[i][jj][2] * acc[i][jj][2] + acc[i][jj][3] * acc[i][jj][3]; }
      s += __shfl_xor(s, 16); s += __shfl_xor(s, 32);
      if (quad == 0) red[row * 2 + wc] = s;
    }
    {
      const int row = tid >> 1, half = tid & 1; const bf16_t* ptr = U + (size_t)(tok0 + row) * LDU + U_KPE + half * 32; float ss = 0.f;
#pragma unroll
      for (int i = 0; i < 4; ++i) { u32x4 v = *(const u32x4*)(ptr + i * 8); float f[8]; unpack8(v, f);
#pragma unroll
        for (int e = 0; e < 8; ++e) ss += f[e] * f[e]; }
      ss += __shfl_xor(ss, 1);
      if (!half) pe_ss[row] = ss;
    }
    __syncthreads();
    bf16_t* Kn = (bf16_t*)(ws + WS_KN) + ((size_t)(b * 6 + h) * 4096 + s0) * 192;
    const float* kn = p.k_norm + L * 192;
#pragma unroll
    for (int i = 0; i < 4; ++i) {
      const int row = wr * 64 + i * 16 + r;
      const float rk = rsqrtf((red[row * 2] + red[row * 2 + 1] + pe_ss[row]) * (1.f / 192.f) + 1e-6f);
      if (wc == 0 && quad == 0) rk_s[row] = rk;
#pragma unroll
      for (int jj = 0; jj < 4; ++jj) {
        const int col = wc * 64 + jj * 16 + quad * 4;
        const f32x4 g = *(const f32x4*)(kn + col);
        f32x4 v = acc[i][jj] * rk * g;
        u32x2 w; w.x = pk2(v[0], v[1]); w.y = pk2(v[2], v[3]);
        *(u32x2*)(Kn + (size_t)row * 192 + col) = w;
      }
    }
    __syncthreads();
    const float* cosT = (const float*)(ws + WS_COS); const float* sinT = (const float*)(ws + WS_SIN);
#pragma unroll 4
    for (int i = 0; i < 16; ++i) {
      const int idx = tid + 256 * i, row = idx >> 5, ii = idx & 31;
      const bf16_t* pe = U + (size_t)(tok0 + row) * LDU + U_KPE;
      const float rk = rk_s[row];
      const float x1 = bf2f(pe[ii]) * rk * kn[128 + ii], x2 = bf2f(pe[32 + ii]) * rk * kn[160 + ii];
      const float c = cosT[(s0 + row) * 32 + ii], sn = sinT[(s0 + row) * 32 + ii];
      Kn[(size_t)row * 192 + 128 + ii] = f2bf(x1 * c - x2 * sn);
      Kn[(size_t)row * 192 + 160 + ii] = f2bf(x2 * c + x1 * sn);
    }
  } else {
    gemm_tile<false>(W + (size_t)(h * 256 + 128) * LDKVW, LDKVW, ckv, LDU, 256, smem, acc, 0, dummy);
    bf16_t* Vt = (bf16_t*)(ws + WS_VT) + ((size_t)(b * 6 + h) * 128) * LDVT + s0;
#pragma unroll
    for (int i = 0; i < 4; ++i) {
      const int d = wr * 64 + i * 16 + r;
#pragma unroll
      for (int jj = 0; jj < 4; ++jj) {
        const int col = wc * 64 + jj * 16 + quad * 4;
        const f32x4 rv = *(const f32x4*)(rs_s + col);
        f32x4 v = acc[i][jj] * rv;
        u32x2 w; w.x = pk2(v[0], v[1]); w.y = pk2(v[2], v[3]);
        *(u32x2*)(Vt + (size_t)d * LDVT + col) = w;
      }
    }
  }
}
DI void q_item(const P& p, int L, int mt_, int nt_, unsigned char* smem) {
  unsigned char* ws = p.ws;
  const bf16_t* U = (const bf16_t*)(ws + WS_U);
  const bf16_t* W = (const bf16_t*)(ws + WS_WQ + L * SZ_WQ);
  bf16_t* Q = (bf16_t*)(ws + WS_QRAW);
  const int tid = otid(), lane = tid & 63, wave = tid >> 6, wr = wave >> 1, wc = wave & 1, r = lane & 15, quad = lane >> 4;
  const int tok0 = mt_ * 128;
  float* rs_s = (float*)(smem + GEMM_SM);
  __syncthreads();
  rows_rstd<512>(U + (size_t)tok0 * LDU + U_CQ, LDU, 1e-6f, rs_s);
  f32x4 acc[4][4]; const float dummy[4] = {1.f, 1.f, 1.f, 1.f};
  gemm_tile<false>(U + (size_t)tok0 * LDU + U_CQ, LDU, W + (size_t)nt_ * 128 * LDQW, LDQW, 512, smem, acc, 0, dummy);
#pragma unroll
  for (int i = 0; i < 4; ++i) {
    const int row = wr * 64 + i * 16 + r; const float rs = rs_s[row];
#pragma unroll
    for (int jj = 0; jj < 4; ++jj) {
      const int col = nt_ * 128 + wc * 64 + jj * 16 + quad * 4;
      f32x4 v = acc[i][jj] * rs;
      u32x2 w; w.x = pk2(v[0], v[1]); w.y = pk2(v[2], v[3]);
      *(u32x2*)(Q + (size_t)(tok0 + row) * 1152 + col) = w;
    }
  }
}
DI void conv_item(const P& p, int L, int it, unsigned char* smem) {
  unsigned char* ws = p.ws;
  const bf16_t* U = (const bf16_t*)(ws + WS_U);
  bf16_t* HC = (bf16_t*)(ws + (L == 0 ? WS_HC : WS_WIN));
  const int tid = otid(), lane = tid & 63, wave = tid >> 6;
  const int tok0 = it * 16, b = tok0 >> 12, s0 = tok0 & 4095;
  bf16_t* glu = (bf16_t*)smem;
  float* part = (float*)(smem + 46 * 512 * 2);
  __syncthreads();
#pragma unroll
  for (int pass = 0; pass < 2; ++pass) {
    u32x4 av[6], gv[6];
#pragma unroll
    for (int k = 0; k < 6; ++k) {
      const int c = tid + 256 * (pass * 6 + k), ri = c >> 6, cc = c & 63, sq = s0 - 30 + ri;
      av[k] = (u32x4){0u, 0u, 0u, 0u}; gv[k] = (u32x4){0u, 0u, 0u, 0u};
      if (c < 46 * 64 && sq >= 0) {
        const bf16_t* up = U + (size_t)(b * 4096 + sq) * LDU;
        av[k] = *(const u32x4*)(up + U_CA + cc * 8); gv[k] = *(const u32x4*)(up + U_CG + cc * 8);
      }
    }
#pragma unroll
    for (int k = 0; k < 6; ++k) {
      const int c = tid + 256 * (pass * 6 + k), ri = c >> 6, cc = c & 63;
      if (c < 46 * 64) {
        float fa[8], fg[8]; unpack8(av[k], fa); unpack8(gv[k], fg);
        u32x4 o;
        o.x = pk2(fa[0] * sigmoidf_(fg[0]), fa[1] * sigmoidf_(fg[1])); o.y = pk2(fa[2] * sigmoidf_(fg[2]), fa[3] * sigmoidf_(fg[3]));
        o.z = pk2(fa[4] * sigmoidf_(fg[4]), fa[5] * sigmoidf_(fg[5])); o.w = pk2(fa[6] * sigmoidf_(fg[6]), fa[7] * sigmoidf_(fg[7]));
        *(u32x4*)(glu + ri * 512 + cc * 8) = o;
      }
    }
  }
  __syncthreads();
  const int ch = tid * 2;
  const float* wdw = p.conv_dw_w + (size_t)L * 31 * 512 + ch;
  float w0[31], w1[31];
#pragma unroll
  for (int j = 0; j < 31; ++j) { w0[j] = wdw[j * 512]; w1[j] = wdw[j * 512 + 1]; }
  const float b0 = p.conv_dw_b[L * 512 + ch], b1 = p.conv_dw_b[L * 512 + ch + 1];
  float o0[16], o1[16];
#pragma unroll
  for (int tb = 0; tb < 4; ++tb) {
    unsigned v[34];
#pragma unroll
    for (int i = 0; i < 34; ++i) v[i] = *(const unsigned*)(glu + (tb * 4 + i) * 512 + ch);
#pragma unroll
    for (int tt = 0; tt < 4; ++tt) {
      float a0 = b0, a1 = b1;
#pragma unroll
      for (int j = 0; j < 31; ++j) { a0 += w0[j] * lo2f(v[tt + j]); a1 += w1[j] * hi2f(v[tt + j]); }
      o0[tb * 4 + tt] = a0; o1[tb * 4 + tt] = a1;
      float s1 = a0 + a1, s2 = a0 * a0 + a1 * a1;
#pragma unroll
      for (int o = 1; o < 64; o <<= 1) { s1 += __shfl_xor(s1, o); s2 += __shfl_xor(s2, o); }
      if (lane == 0) { part[((tb * 4 + tt) * 4 + wave) * 2] = s1; part[((tb * 4 + tt) * 4 + wave) * 2 + 1] = s2; }
    }
  }
  __syncthreads();
  const float g0 = p.conv_ln_g[L * 512 + ch], g1 = p.conv_ln_g[L * 512 + ch + 1], lb0 = p.conv_ln_b[L * 512 + ch], lb1 = p.conv_ln_b[L * 512 + ch + 1];
#pragma unroll
  for (int tk = 0; tk < 16; ++tk) {
    const float S1 = part[(tk * 4 + 0) * 2] + part[(tk * 4 + 1) * 2] + part[(tk * 4 + 2) * 2] + part[(tk * 4 + 3) * 2];
    const float S2 = part[(tk * 4 + 0) * 2 + 1] + part[(tk * 4 + 1) * 2 + 1] + part[(tk * 4 + 2) * 2 + 1] + part[(tk * 4 + 3) * 2 + 1];
    const float mean = S1 * (1.f / 512.f); float var = S2 * (1.f / 512.f) - mean * mean; var = var < 0.f ? 0.f : var;
    const float rstd = rsqrtf(var + 1e-5f);
    const float y0 = (o0[tk] - mean) * rstd * g0 + lb0, y1 = (o1[tk] - mean) * rstd * g1 + lb1;
    *(unsigned*)(HC + (size_t)(tok0 + tk) * LDHC + ch) = pk2(siluf_(y0), siluf_(y1));
  }
}
DI void ssdconv_item(const P& p, int L, int it) {
  unsigned char* ws = p.ws;
  const bf16_t* U = (const bf16_t*)(ws + WS_U);
  bf16_t* XC = (bf16_t*)(ws + WS_XBCC);
  const int tid = otid();
  const int tok0 = it * 16, b = tok0 >> 12, s0 = tok0 & 4095;
  const float* cw = p.ssd_conv_w + (size_t)L * 4 * 1280; const float* cb = p.ssd_conv_b + L * 1280;
#pragma unroll 1
  for (int c0 = tid; c0 < 16 * 160; c0 += 512) {
    u32x4 v[2][4];
#pragma unroll
    for (int u = 0; u < 2; ++u) {
      const int c = c0 + 256 * u, tk = c / 160, cc = c % 160, sq = s0 + tk;
#pragma unroll
      for (int j = 0; j < 4; ++j) {
        const int sp = sq - 3 + j;
        v[u][j] = (u32x4){0u, 0u, 0u, 0u};
        if (sp >= 0) v[u][j] = *(const u32x4*)(U + (size_t)(b * 4096 + sp) * LDU + U_XBC + cc * 8);
      }
    }
#pragma unroll
    for (int u = 0; u < 2; ++u) {
      const int c = c0 + 256 * u, tk = c / 160, cc = c % 160;
      float a[8];
      { f32x4 b0 = *(const f32x4*)(cb + cc * 8), b1 = *(const f32x4*)(cb + cc * 8 + 4); a[0] = b0[0]; a[1] = b0[1]; a[2] = b0[2]; a[3] = b0[3]; a[4] = b1[0]; a[5] = b1[1]; a[6] = b1[2]; a[7] = b1[3]; }
#pragma unroll
      for (int j = 0; j < 4; ++j) {
        float f[8]; unpack8(v[u][j], f);
        f32x4 w0 = *(const f32x4*)(cw + j * 1280 + cc * 8), w1 = *(const f32x4*)(cw + j * 1280 + cc * 8 + 4);
        a[0] += f[0] * w0[0]; a[1] += f[1] * w0[1]; a[2] += f[2] * w0[2]; a[3] += f[3] * w0[3];
        a[4] += f[4] * w1[0]; a[5] += f[5] * w1[1]; a[6] += f[6] * w1[2]; a[7] += f[7] * w1[3];
      }
      u32x4 o; o.x = pk2(siluf_(a[0]), siluf_(a[1])); o.y = pk2(siluf_(a[2]), siluf_(a[3])); o.z = pk2(siluf_(a[4]), siluf_(a[5])); o.w = pk2(siluf_(a[6]), siluf_(a[7]));
      *(u32x4*)(XC + (size_t)(tok0 + tk) * 1280 + cc * 8) = o;
    }
  }
}

DI void dt_item(const P& p, int L, int it, unsigned char* smem) {
  unsigned char* ws = p.ws;
  const float* dtraw = (const float*)(ws + WS_DTRAW);
  float* dtg = (float*)(ws + WS_DT); float* acs = (float*)(ws + WS_ACS);
  const int tid = otid(), tok0 = it * 128;
  float* a_s = (float*)smem;
  __syncthreads();
  for (int idx = tid; idx < 1536; idx += 256) {
    const int l = idx / 12, h = idx % 12;
    const float raw = dtraw[(size_t)(tok0 + l) * 12 + h] + p.ssd_dt_bias[L * 12 + h];
    const float dtv = fmaxf(raw, 0.f) + log1pf(expf(-fabsf(raw)));
    dtg[(size_t)(tok0 + l) * 12 + h] = dtv;
    a_s[h * 128 + l] = dtv * (-expf(p.ssd_A_log[L * 12 + h]));
  }
  __syncthreads();
  for (int idx = tid; idx < 1536; idx += 256) {
    const int l = idx & 127, h = idx >> 7;
    float cs = 0.f;
    for (int i = 0; i <= l; ++i) cs += a_s[h * 128 + i];
    acs[(size_t)(tok0 + l) * 12 + h] = cs;
  }
  if (tid < 128) ((float*)(ws + WS_SSS))[tok0 + tid] = 0.f;
}
DI void attn_item(const P& p, int L, int b, int h, int qb, int t_lo, int t_hi, int part, unsigned char* smem) {
  unsigned char* ws = p.ws;
  const bf16_t* U = (const bf16_t*)(ws + WS_U);
  const bf16_t* Qr = (const bf16_t*)(ws + WS_QRAW);
  const bf16_t* Kg = (const bf16_t*)(ws + WS_KN) + (size_t)(b * 6 + h) * 4096 * 192;
  const bf16_t* Vg = (const bf16_t*)(ws + WS_VT) + (size_t)(b * 6 + h) * 128 * LDVT;
  bf16_t* MIX = (bf16_t*)(ws + WS_XBA);
  const float* cosT = (const float*)(ws + WS_COS); const float* sinT = (const float*)(ws + WS_SIN);
  const int tid = otid(), lane = tid & 63, w = tid >> 6, r = lane & 15, quad = lane >> 4;
  bf16_t* Ks = (bf16_t*)smem;
  bf16_t* Vs = (bf16_t*)(smem + 2 * 64 * 192 * 2);
  const int qrow0 = qb * 128 + 32 * w;
  const float QSCALE = 0.07216878364870322f * 1.4426950408889634f;
  {
    bf16_t* Qs = (bf16_t*)smem;
    const int prow = tid >> 1, half = tid & 1, pos = qb * 128 + prow;
    const bf16_t* qp = Qr + (size_t)(b * 4096 + pos) * 1152 + h * 192 + half * 96;
    float ss = 0.f;
#pragma unroll
    for (int c = 0; c < 12; ++c) { const u32x4 raw = *(const u32x4*)(qp + c * 8); float f[8]; unpack8(raw, f);
#pragma unroll
      for (int e = 0; e < 8; ++e) ss += f[e] * f[e]; }
    ss += __shfl_xor(ss, 1);
    const float rq = rsqrtf(ss * (1.f / 192.f) + 1e-6f) * QSCALE;
    const float* qn = p.q_norm + L * 192 + half * 96;
    bf16_t* qs = Qs + prow * 200 + half * 96;
    const int nplain = half ? 4 : 12;
#pragma unroll 1
    for (int c = 0; c < nplain; ++c) {
      const u32x4 raw = *(const u32x4*)(qp + c * 8); float f[8]; unpack8(raw, f);
      const f32x4 g0 = *(const f32x4*)(qn + c * 8), g1 = *(const f32x4*)(qn + c * 8 + 4);
      u32x4 wv; wv.x = pk2(f[0] * rq * g0[0], f[1] * rq * g0[1]); wv.y = pk2(f[2] * rq * g0[2], f[3] * rq * g0[3]);
      wv.z = pk2(f[4] * rq * g1[0], f[5] * rq * g1[1]); wv.w = pk2(f[6] * rq * g1[2], f[7] * rq * g1[3]);
      *(u32x4*)(qs + c * 8) = wv;
    }
    if (half) {
#pragma unroll 1
      for (int c = 4; c < 8; ++c) {
        const u32x4 rawa = *(const u32x4*)(qp + c * 8), rawb = *(const u32x4*)(qp + (c + 4) * 8);
        float fa[8], fb[8]; unpack8(rawa, fa); unpack8(rawb, fb);
        float ra[8], rb[8];
#pragma unroll
        for (int e = 0; e < 8; ++e) {
          const float xa = fa[e] * rq * qn[c * 8 + e], xb = fb[e] * rq * qn[(c + 4) * 8 + e];
          const float cc = cosT[pos * 32 + (c - 4) * 8 + e], sn = sinT[pos * 32 + (c - 4) * 8 + e];
          ra[e] = xa * cc - xb * sn; rb[e] = xb * cc + xa * sn;
        }
        u32x4 wa, wb;
        wa.x = pk2(ra[0], ra[1]); wa.y = pk2(ra[2], ra[3]); wa.z = pk2(ra[4], ra[5]); wa.w = pk2(ra[6], ra[7]);
        wb.x = pk2(rb[0], rb[1]); wb.y = pk2(rb[2], rb[3]); wb.z = pk2(rb[4], rb[5]); wb.w = pk2(rb[6], rb[7]);
        *(u32x4*)(qs + c * 8) = wa; *(u32x4*)(qs + (c + 4) * 8) = wb;
      }
    }
  }
  __syncthreads();
  bf16x8 qf[2][6];
#pragma unroll
  for (int qt = 0; qt < 2; ++qt)
#pragma unroll
    for (int ks = 0; ks < 6; ++ks) qf[qt][ks] = *(const bf16x8*)((const bf16_t*)smem + (32 * w + 16 * qt + r) * 200 + ks * 32 + quad * 8);
  int kgo[6];
#pragma unroll
  for (int i = 0; i < 6; ++i) { const int c = i * 256 + tid, row = c / 24, pc = c % 24; kgo[i] = row * 192 + ((pc & 24) | ((pc & 7) ^ (row & 7))) * 8; }
  const int vkey = ((tid >> 3) & 7) ^ ((tid >> 6) & 1);
  const size_t vgo = (size_t)(tid >> 3) * LDVT + ((tid & 7) ^ vkey) * 8;
#define ATT_DMAK(buf, jt) { _Pragma("unroll") for (int i = 0; i < 6; ++i)                                                                   \
    __builtin_amdgcn_global_load_lds((const unsigned*)(Kg + (size_t)(jt) * 64 * 192 + kgo[i]), (unsigned*)(Ks + (buf) * 64 * 192 + (i * 256 + tid) * 8), 16, 0, 0); }
#define ATT_DMAV(jt) { _Pragma("unroll") for (int i = 0; i < 4; ++i)                                                                        \
    __builtin_amdgcn_global_load_lds((const unsigned*)(Vg + vgo + (size_t)i * 32 * LDVT + (jt) * 64), (unsigned*)(Vs + (i * 256 + tid) * 8), 16, 0, 0); }
  __syncthreads();
  ATT_DMAK(0, t_lo)
  float m[2] = {-INFINITY, -INFINITY}, l[2] = {0.f, 0.f};
  f32x4 o[8][2];
#pragma unroll
  for (int dt = 0; dt < 8; ++dt) { o[dt][0] = (f32x4){0.f, 0.f, 0.f, 0.f}; o[dt][1] = (f32x4){0.f, 0.f, 0.f, 0.f}; }
  for (int jt = t_lo; jt < t_hi; ++jt) {
    const int kcur = ((jt - t_lo) & 1) * 64 * 192;
    __syncthreads();
    ATT_DMAV(jt)
    { const int jn = (jt + 1 < t_hi) ? jt + 1 : jt; ATT_DMAK((((jt - t_lo) & 1) ^ 1), jn) }
    const int kstart = jt * 64;
    const bool active = (kstart <= qrow0 + 31);
    f32x4 s[4][2];
    if (active) {
#pragma unroll
      for (int kt = 0; kt < 4; ++kt) { s[kt][0] = (f32x4){0.f, 0.f, 0.f, 0.f}; s[kt][1] = (f32x4){0.f, 0.f, 0.f, 0.f}; }
      {
        const bf16_t* kbase = Ks + kcur + r * 192;
        const int kx0 = (quad ^ (r & 7)) * 8, kx1 = kx0 ^ 32;
        bf16x8 kf[2][4];
#pragma unroll
        for (int kt = 0; kt < 4; ++kt) kf[0][kt] = *(const bf16x8*)(kbase + kt * 16 * 192 + kx0);
#pragma unroll
        for (int ks = 0; ks < 6; ++ks) {
          if (ks < 5) {
#pragma unroll
            for (int kt = 0; kt < 4; ++kt) kf[(ks + 1) & 1][kt] = *(const bf16x8*)(kbase + kt * 16 * 192 + ((ks + 1) >> 1) * 64 + (((ks + 1) & 1) ? kx1 : kx0));
          }
#pragma unroll
          for (int kt = 0; kt < 4; ++kt) {
            s[kt][0] = mfma16(kf[ks & 1][kt], qf[0][ks], s[kt][0]);
            s[kt][1] = mfma16(kf[ks & 1][kt], qf[1][ks], s[kt][1]);
          }
          __builtin_amdgcn_sched_barrier(0);
        }
      }
      const bool need_mask = (kstart + 63 > qrow0);
#pragma unroll
      for (int qt = 0; qt < 2; ++qt) {
        const int qpos = qrow0 + 16 * qt + r;
        if (need_mask) {
#pragma unroll
          for (int kt = 0; kt < 4; ++kt)
#pragma unroll
            for (int t = 0; t < 4; ++t) if (kstart + kt * 16 + quad * 4 + t > qpos) s[kt][qt][t] = -INFINITY;
        }
        float mx = -INFINITY;
#pragma unroll
        for (int kt = 0; kt < 4; ++kt) mx = fmaxf(mx, fmaxf(fmaxf(s[kt][qt][0], s[kt][qt][1]), fmaxf(s[kt][qt][2], s[kt][qt][3])));
        mx = fmaxf(mx, __shfl_xor(mx, 16)); mx = fmaxf(mx, __shfl_xor(mx, 32));
        if (!__all(mx - m[qt] <= 8.f)) {
          const float mnew = fmaxf(m[qt], mx);
          const float alpha = __builtin_amdgcn_exp2f(m[qt] - mnew);
          m[qt] = mnew; l[qt] *= alpha;
#pragma unroll
          for (int dt = 0; dt < 8; ++dt) o[dt][qt] *= alpha;
        }
        const float mref = m[qt];
        float rsum = 0.f;
#pragma unroll
        for (int kt = 0; kt < 4; ++kt)
#pragma unroll
          for (int t = 0; t < 4; ++t) { const float pv = __builtin_amdgcn_exp2f(s[kt][qt][t] - mref); s[kt][qt][t] = pv; rsum += pv; }
        l[qt] += rsum;
      }
    }
    __syncthreads();
    if (active) {
      const int vkr = (r & 7) ^ ((r >> 3) & 1), vx8 = ((quad >> 1) ^ vkr) * 8, vq = (quad & 1) * 4;
#pragma unroll
      for (int k2 = 0; k2 < 2; ++k2) {
        const bf16x8 pf0 = pack8(s[2 * k2][0][0], s[2 * k2][0][1], s[2 * k2][0][2], s[2 * k2][0][3], s[2 * k2 + 1][0][0], s[2 * k2 + 1][0][1], s[2 * k2 + 1][0][2], s[2 * k2 + 1][0][3]);
        const bf16x8 pf1 = pack8(s[2 * k2][1][0], s[2 * k2][1][1], s[2 * k2][1][2], s[2 * k2][1][3], s[2 * k2 + 1][1][0], s[2 * k2 + 1][1][1], s[2 * k2 + 1][1][2], s[2 * k2 + 1][1][3]);
        const bf16_t* vb0 = Vs + r * 64 + (vx8 ^ (k2 * 32)) + vq;
        const bf16_t* vb1 = Vs + r * 64 + (vx8 ^ (k2 * 32 + 16)) + vq;
        bf16x4 va[2][2], vb[2][2];
#pragma unroll
        for (int u = 0; u < 2; ++u) { va[0][u] = *(const bf16x4*)(vb0 + u * 16 * 64); vb[0][u] = *(const bf16x4*)(vb1 + u * 16 * 64); }
#pragma unroll
        for (int d2 = 0; d2 < 4; ++d2) {
          if (d2 < 3) {
#pragma unroll
            for (int u = 0; u < 2; ++u) { va[(d2 + 1) & 1][u] = *(const bf16x4*)(vb0 + ((d2 + 1) * 2 + u) * 16 * 64); vb[(d2 + 1) & 1][u] = *(const bf16x4*)(vb1 + ((d2 + 1) * 2 + u) * 16 * 64); }
          }
#pragma unroll
          for (int u = 0; u < 2; ++u) {
            const bf16x8 vf = __builtin_shufflevector(va[d2 & 1][u], vb[d2 & 1][u], 0, 1, 2, 3, 4, 5, 6, 7);
            o[d2 * 2 + u][0] = mfma16(vf, pf0, o[d2 * 2 + u][0]);
            o[d2 * 2 + u][1] = mfma16(vf, pf1, o[d2 * 2 + u][1]);
          }
        }
      }
    }
  }
#undef ATT_DMAK
#undef ATT_DMAV
#pragma unroll
  for (int qt = 0; qt < 2; ++qt) {
    float lt = l[qt]; lt += __shfl_xor(lt, 16); lt += __shfl_xor(lt, 32);
    const float inv = 1.f / lt;
    if (part < 0) {
      const size_t tok = (size_t)b * 4096 + qrow0 + 16 * qt + r;
#pragma unroll
      for (int dt = 0; dt < 8; ++dt) {
        const int col = h * 128 + dt * 16 + quad * 4;
        const u32x2 g = *(const u32x2*)(U + tok * LDU + U_GMLA + col);
        f32x4 v = o[dt][qt] * inv;
        u32x2 wv; wv.x = pk2(v[0] * siluf_(lo2f(g.x)), v[1] * siluf_(hi2f(g.x))); wv.y = pk2(v[2] * siluf_(lo2f(g.y)), v[3] * siluf_(hi2f(g.y)));
        *(u32x2*)(MIX + tok * LDX + MIX_MLA + col) = wv;
      }
    } else {
      const size_t slot = ((size_t)(b * 6 + h) * 16 + (qb - 16)) * 2 + part;
      const int row = 32 * w + 16 * qt + r;
      bf16_t* po = (bf16_t*)(ws + WS_PO) + (slot * 128 + row) * 128;
#pragma unroll
      for (int dt = 0; dt < 8; ++dt) {
        f32x4 v = o[dt][qt] * inv;
        u32x2 wv; wv.x = pk2(v[0], v[1]); wv.y = pk2(v[2], v[3]);
        *(u32x2*)(po + dt * 16 + quad * 4) = wv;
      }
      if (quad == 0) { float* pml = (float*)(ws + WS_PML) + (slot * 128 + row) * 2; pml[0] = m[qt]; pml[1] = lt; }
    }
  }
}

DI void pw_item(const P& p, int L, int mt_, int nt_, unsigned char* smem) {
  unsigned char* ws = p.ws;
  const bf16_t* U = (const bf16_t*)(ws + WS_U);
  const bf16_t* HC = (const bf16_t*)(ws + (L == 0 ? WS_HC : WS_WIN));
  const bf16_t* W = (const bf16_t*)(ws + WS_WPW + L * SZ_WPW);
  bf16_t* MIX = (bf16_t*)(ws + WS_XBA);
  const int tid = otid(), lane = tid & 63, wave = tid >> 6, wr = wave >> 1, wc = wave & 1, r = lane & 15, quad = lane >> 4;
  f32x4 acc[4][4]; const float dummy[4] = {1.f, 1.f, 1.f, 1.f};
  gemm_tile<false>(HC + (size_t)mt_ * 128 * LDHC, LDHC, W + (size_t)nt_ * 128 * LDPW, LDPW, 512, smem, acc, 0, dummy);
#pragma unroll
  for (int i = 0; i < 4; ++i) {
    const size_t tok = (size_t)mt_ * 128 + wr * 64 + i * 16 + r;
#pragma unroll
    for (int jj = 0; jj < 4; ++jj) {
      const int col = nt_ * 128 + wc * 64 + jj * 16 + quad * 4;
      const u32x2 g = *(const u32x2*)(U + tok * LDU + U_GCONV + col);
      const f32x4 v = acc[i][jj];
      u32x2 wv; wv.x = pk2(v[0] * siluf_(lo2f(g.x)), v[1] * siluf_(hi2f(g.x))); wv.y = pk2(v[2] * siluf_(lo2f(g.y)), v[3] * siluf_(hi2f(g.y)));
      *(u32x2*)(MIX + tok * LDX + MIX_CONV + col) = wv;
    }
  }
}
DI void ssd_item(const P& p, int b, int c, int h, unsigned char* smem) {
  unsigned char* ws = p.ws;
  const bf16_t* XC = (const bf16_t*)(ws + WS_XBCC);
  const float* dtg = (const float*)(ws + WS_DT); const float* acsg = (const float*)(ws + WS_ACS);
  float* YD = (float*)(ws + WS_XBB);
  float* ST = (float*)(ws + WS_STATES);
  const int tid = otid(), lane = tid & 63, w = tid >> 6, r = lane & 15, quad = lane >> 4;
  const int g = h / 6; const size_t tok0 = (size_t)b * 4096 + c * 128;
  bf16_t* R0 = (bf16_t*)smem;
  bf16_t* R1 = (bf16_t*)(smem + 34816);
  float* acs_s = (float*)(smem + 69632);
  float* dt_s = acs_s + 128;
  __syncthreads();
  u32x4 braw[8], xraw[4];
#pragma unroll
  for (int i = 0; i < 8; ++i) {
    const int cidx = tid + 256 * i, row = cidx >> 4, cc = cidx & 15;
    *(u32x4*)(R0 + row * 136 + cc * 8) = *(const u32x4*)(XC + (tok0 + row) * 1280 + g * 128 + cc * 8 + 1024);
  }
#pragma unroll
  for (int i = 0; i < 8; ++i) { const int cidx = tid + 256 * i, lrow = cidx & 127, cc = cidx >> 7; braw[i] = *(const u32x4*)(XC + (tok0 + lrow) * 1280 + 768 + g * 128 + cc * 8); }
#pragma unroll
  for (int i = 0; i < 4; ++i) { const int cidx = tid + 256 * i, lrow = cidx & 127, cc = cidx >> 7; xraw[i] = *(const u32x4*)(XC + (tok0 + lrow) * 1280 + h * 64 + cc * 8); }
#pragma unroll
  for (int i = 0; i < 8; ++i) { const int cidx = tid + 256 * i, lrow = cidx & 127, cc = cidx >> 7; *(u32x4*)(R1 + lrow * 136 + cc * 8) = braw[i]; }
  if (tid < 128) { acs_s[tid] = acsg[(tok0 + tid) * 12 + h]; dt_s[tid] = dtg[(tok0 + tid) * 12 + h]; }
  __syncthreads();
  {
    f32x4 acc[2][8];
#pragma unroll
    for (int i = 0; i < 2; ++i)
#pragma unroll
      for (int j = 0; j < 8; ++j) acc[i][j] = (f32x4){0.f, 0.f, 0.f, 0.f};
#pragma unroll
    for (int ks = 0; ks < 4; ++ks) {
      bf16x8 cf[2];
#pragma unroll
      for (int i = 0; i < 2; ++i) cf[i] = *(const bf16x8*)(R0 + (32 * w + i * 16 + r) * 136 + ks * 32 + quad * 8);
#pragma unroll
      for (int j = 0; j < 8; ++j) {
        const bf16x8 bfr = *(const bf16x8*)(R1 + (j * 16 + r) * 136 + ks * 32 + quad * 8);
        acc[0][j] = mfma16(bfr, cf[0], acc[0][j]); acc[1][j] = mfma16(bfr, cf[1], acc[1][j]);
      }
    }
    __syncthreads();
#pragma unroll
    for (int i = 0; i < 2; ++i) {
      const int lrow = 32 * w + i * 16 + r; const float al = acs_s[lrow];
#pragma unroll
      for (int j = 0; j < 8; ++j) {
        const int s = j * 16 + quad * 4; float mv[4];
#pragma unroll
        for (int t = 0; t < 4; ++t) mv[t] = (s + t <= lrow) ? acc[i][j][t] * __expf(al - acs_s[s + t]) : 0.f;
        u32x2 wv; wv.x = pk2(mv[0], mv[1]); wv.y = pk2(mv[2], mv[3]);
        *(u32x2*)(R0 + lrow * 136 + s) = wv;
      }
    }
  }
  {
    const float alast = acs_s[127];
#pragma unroll
    for (int i = 0; i < 4; ++i) {
      const int cidx = tid + 256 * i, lrow = cidx & 127, cc = cidx >> 7;
      float f[8]; unpack8(xraw[i], f);
      const float d1 = dt_s[lrow], d2 = d1 * __expf(alast - acs_s[lrow]);
#pragma unroll
      for (int e = 0; e < 8; ++e) { R1[(cc * 8 + e) * 136 + lrow] = f2bf(f[e] * d1); R1[(64 + cc * 8 + e) * 136 + lrow] = f2bf(f[e] * d2); }
    }
  }
  __syncthreads();
  {
    f32x4 acc[2][4];
#pragma unroll
    for (int i = 0; i < 2; ++i)
#pragma unroll
      for (int j = 0; j < 4; ++j) acc[i][j] = (f32x4){0.f, 0.f, 0.f, 0.f};
#pragma unroll
    for (int ks = 0; ks < 4; ++ks) {
      bf16x8 mf[2];
#pragma unroll
      for (int i = 0; i < 2; ++i) mf[i] = *(const bf16x8*)(R0 + (32 * w + i * 16 + r) * 136 + ks * 32 + quad * 8);
#pragma unroll
      for (int j = 0; j < 4; ++j) {
        const bf16x8 xf = *(const bf16x8*)(R1 + (j * 16 + r) * 136 + ks * 32 + quad * 8);
        acc[0][j] = mfma16(xf, mf[0], acc[0][j]); acc[1][j] = mfma16(xf, mf[1], acc[1][j]);
      }
    }
#pragma unroll
    for (int i = 0; i < 2; ++i)
#pragma unroll
      for (int j = 0; j < 4; ++j) *(f32x4*)(YD + (tok0 + 32 * w + i * 16 + r) * 768 + h * 64 + j * 16 + quad * 4) = acc[i][j];
  }
  __syncthreads();
#pragma unroll
  for (int i = 0; i < 8; ++i) {
    const int cidx = tid + 256 * i, lrow = cidx & 127, cc = cidx >> 7;
    const bf16x8 v = __builtin_bit_cast(bf16x8, braw[i]);
#pragma unroll
    for (int e = 0; e < 8; ++e) R0[(cc * 8 + e) * 136 + lrow] = (bf16_t)v[e];
  }
  __syncthreads();
  {
    f32x4 acc[8];
#pragma unroll
    for (int j = 0; j < 8; ++j) acc[j] = (f32x4){0.f, 0.f, 0.f, 0.f};
#pragma unroll
    for (int ks = 0; ks < 4; ++ks) {
      const bf16x8 xf = *(const bf16x8*)(R1 + (64 + 16 * w + r) * 136 + ks * 32 + quad * 8);
#pragma unroll
      for (int j = 0; j < 8; ++j) {
        const bf16x8 bfr = *(const bf16x8*)(R0 + (j * 16 + r) * 136 + ks * 32 + quad * 8);
        acc[j] = mfma16(bfr, xf, acc[j]);
      }
    }
    float* dst = ST + ((((size_t)b * 32 + c) * 12 + h) * 64 + 16 * w + r) * 128;
#pragma unroll
    for (int j = 0; j < 8; ++j) *(f32x4*)(dst + j * 16 + quad * 4) = acc[j];
  }
}
DI void scan_item(const P& p, int it) {
  unsigned char* ws = p.ws;
  const float* ST = (const float*)(ws + WS_STATES); const float* acsg = (const float*)(ws + WS_ACS);
  bf16_t* PV = (bf16_t*)(ws + WS_QRAW);
  const int gi = it * 256 + otid(), n4 = gi & 31, pp = (gi >> 5) & 63, bh = gi >> 11, h = bh % 12, b = bh / 12;
  f32x4 st = (f32x4){0.f, 0.f, 0.f, 0.f};
  const size_t off0 = (((size_t)b * 32 * 12 + h) * 64 + pp) * 128 + n4 * 4;
  const float* ap = acsg + ((size_t)b * 4096 + 127) * 12 + h;
#pragma unroll 1
  for (int c0 = 0; c0 < 32; c0 += 16) {
    f32x4 sv[16]; float dc[16];
#pragma unroll
    for (int k = 0; k < 16; ++k) { sv[k] = *(const f32x4*)(ST + off0 + (size_t)(c0 + k) * (12 * 64 * 128)); dc[k] = ap[(size_t)(c0 + k) * 128 * 12]; }
#pragma unroll
    for (int k = 0; k < 16; ++k) {
      u32x2 wv; wv.x = pk2(st[0], st[1]); wv.y = pk2(st[2], st[3]);
      *(u32x2*)(PV + off0 + (size_t)(c0 + k) * (12 * 64 * 128)) = wv;
      st = st * __expf(dc[k]) + sv[k];
    }
  }
}

DI void combine_item(const P& p, int sidx) {
  unsigned char* ws = p.ws;
  const bf16_t* U = (const bf16_t*)(ws + WS_U);
  const bf16_t* PO = (const bf16_t*)(ws + WS_PO);
  const float* PML = (const float*)(ws + WS_PML);
  bf16_t* MIX = (bf16_t*)(ws + WS_XBA);
  const int tid = otid(), row = tid >> 1, half = tid & 1;
  const int bh = sidx >> 4, qb = 16 + (sidx & 15), b = bh / 6, h = bh % 6;
  const size_t tok = (size_t)b * 4096 + qb * 128 + row;
  const size_t s0 = (size_t)sidx * 2, s1 = s0 + 1;
  const float m0 = PML[(s0 * 128 + row) * 2], l0 = PML[(s0 * 128 + row) * 2 + 1], m1 = PML[(s1 * 128 + row) * 2], l1 = PML[(s1 * 128 + row) * 2 + 1];
  const float mm = fmaxf(m0, m1);
  float w0 = l0 * __builtin_amdgcn_exp2f(m0 - mm), w1 = l1 * __builtin_amdgcn_exp2f(m1 - mm);
  const float inv = 1.f / (w0 + w1); w0 *= inv; w1 *= inv;
  const bf16_t* p0 = PO + (s0 * 128 + row) * 128 + half * 64; const bf16_t* p1 = PO + (s1 * 128 + row) * 128 + half * 64;
  const bf16_t* gp = U + tok * LDU + U_GMLA + h * 128 + half * 64;
  bf16_t* mp = MIX + tok * LDX + MIX_MLA + h * 128 + half * 64;
  u32x4 a[8], c[8], g[8];
#pragma unroll
  for (int i = 0; i < 8; ++i) { a[i] = *(const u32x4*)(p0 + i * 8); c[i] = *(const u32x4*)(p1 + i * 8); g[i] = *(const u32x4*)(gp + i * 8); }
#pragma unroll
  for (int i = 0; i < 8; ++i) {
    float fa[8], fc[8], fg[8]; unpack8(a[i], fa); unpack8(c[i], fc); unpack8(g[i], fg);
    float o[8];
#pragma unroll
    for (int e = 0; e < 8; ++e) o[e] = (fa[e] * w0 + fc[e] * w1) * siluf_(fg[e]);
    u32x4 wv; wv.x = pk2(o[0], o[1]); wv.y = pk2(o[2], o[3]); wv.z = pk2(o[4], o[5]); wv.w = pk2(o[6], o[7]);
    *(u32x4*)(mp + i * 8) = wv;
  }
}

DI void yoff_item(const P& p, int L, int b, int c, int h, unsigned char* smem) {
  unsigned char* ws = p.ws;
  const bf16_t* U = (const bf16_t*)(ws + WS_U);
  const bf16_t* XC = (const bf16_t*)(ws + WS_XBCC);
  const bf16_t* PV = (const bf16_t*)(ws + WS_QRAW);
  const float* acsg = (const float*)(ws + WS_ACS);
  const float* YD = (const float*)(ws + WS_XBB);
  bf16_t* MIX = (bf16_t*)(ws + WS_XBA);
  float* sss = (float*)(ws + WS_SSS);
  const int tid = otid(), lane = tid & 63, w = tid >> 6, r = lane & 15, quad = lane >> 4;
  const int g = h / 6; const size_t tok0 = (size_t)b * 4096 + c * 128;
  bf16_t* R0 = (bf16_t*)smem;
  bf16_t* R1 = (bf16_t*)(smem + 34816);
  float* acs_s = (float*)(smem + 69632);
  f32x4 pyd[2][4]; u32x2 pxv[2][4], pzv[2][4];
#pragma unroll
  for (int i = 0; i < 2; ++i)
#pragma unroll
    for (int j = 0; j < 4; ++j) {
      const size_t tok = tok0 + 32 * w + i * 16 + r; const int col = h * 64 + j * 16 + quad * 4;
      pyd[i][j] = *(const f32x4*)(YD + tok * 768 + col);
      pxv[i][j] = *(const u32x2*)(XC + tok * 1280 + col);
      pzv[i][j] = *(const u32x2*)(U + tok * LDU + (col < Z_HEAD ? U_Z + col : U_ZT + (col - Z_HEAD)));
    }
  __syncthreads();
#pragma unroll
  for (int i = 0; i < 8; ++i) {
    const int cidx = tid + 256 * i, row = cidx >> 4, cc = cidx & 15;
    *(u32x4*)(R0 + row * 136 + cc * 8) = *(const u32x4*)(XC + (tok0 + row) * 1280 + 1024 + g * 128 + cc * 8);
  }
#pragma unroll
  for (int i = 0; i < 4; ++i) {
    const int cidx = tid + 256 * i, row = cidx >> 4, cc = cidx & 15;
    *(u32x4*)(R1 + row * 136 + cc * 8) = *(const u32x4*)(PV + ((((size_t)b * 32 + c) * 12 + h) * 64 + row) * 128 + cc * 8);
  }
  if (tid < 128) acs_s[tid] = acsg[(tok0 + tid) * 12 + h];
  __syncthreads();
  f32x4 acc[2][4];
#pragma unroll
  for (int i = 0; i < 2; ++i)
#pragma unroll
    for (int j = 0; j < 4; ++j) acc[i][j] = (f32x4){0.f, 0.f, 0.f, 0.f};
#pragma unroll
  for (int ks = 0; ks < 4; ++ks) {
    bf16x8 cf[2];
#pragma unroll
    for (int i = 0; i < 2; ++i) cf[i] = *(const bf16x8*)(R0 + (32 * w + i * 16 + r) * 136 + ks * 32 + quad * 8);
#pragma unroll
    for (int j = 0; j < 4; ++j) {
      const bf16x8 pf = *(const bf16x8*)(R1 + (j * 16 + r) * 136 + ks * 32 + quad * 8);
      acc[0][j] = mfma16(pf, cf[0], acc[0][j]); acc[1][j] = mfma16(pf, cf[1], acc[1][j]);
    }
  }
  const float Dh = p.ssd_D[L * 12 + h];
#pragma unroll
  for (int i = 0; i < 2; ++i) {
    const int lrow = 32 * w + i * 16 + r; const size_t tok = tok0 + lrow; const float e = __expf(acs_s[lrow]);
    float ss = 0.f;
#pragma unroll
    for (int j = 0; j < 4; ++j) {
      const int col = h * 64 + j * 16 + quad * 4;
      const f32x4 yd = pyd[i][j]; const u32x2 xv = pxv[i][j]; const u32x2 zv = pzv[i][j];
      const float y0 = acc[i][j][0] * e + yd[0] + Dh * lo2f(xv.x), y1 = acc[i][j][1] * e + yd[1] + Dh * hi2f(xv.x);
      const float y2 = acc[i][j][2] * e + yd[2] + Dh * lo2f(xv.y), y3 = acc[i][j][3] * e + yd[3] + Dh * hi2f(xv.y);
      const float g0 = y0 * siluf_(lo2f(zv.x)), g1 = y1 * siluf_(hi2f(zv.x)), g2 = y2 * siluf_(lo2f(zv.y)), g3 = y3 * siluf_(hi2f(zv.y));
      ss += g0 * g0 + g1 * g1 + g2 * g2 + g3 * g3;
      u32x2 wv; wv.x = pk2(g0, g1); wv.y = pk2(g2, g3);
      *(u32x2*)(MIX + tok * LDX + MIX_SSD + col) = wv;
    }
    ss += __shfl_xor(ss, 16); ss += __shfl_xor(ss, 32);
    if (quad == 0) atomicAdd(sss + tok, ss);
  }
}

DI void phase6(const P& p, int L, unsigned char* smem, int rep) {
  unsigned char* ws = p.ws;
  const bf16_t* MIX = (const bf16_t*)(ws + WS_XBA);
  const bf16_t* W = (const bf16_t*)(ws + WS_WOUT + L * SZ_WOUT);
  const float* sss = (const float*)(ws + WS_SSS);
  float* ssx = (float*)(ws + WS_SSX);
  bf16_t* XB = (bf16_t*)(ws + WS_XBB);
  const float* xin = (L == 0) ? p.x : (const float*)p.out;
  const int tid = otid(), lane = tid & 63, wave = tid >> 6, wr = wave >> 1, wc = wave & 1, r = lane & 15, quad = lane >> 4;
  constexpr int NTILE = 64 * 16;
  for (int t = blockIdx.x; t < NTILE; t += gridDim.x) {
    const int mt_ = t >> 4, nt_ = t & 15;
    float rsc[4];
#pragma unroll
    for (int i = 0; i < 4; ++i) rsc[i] = rsqrtf(sss[mt_ * 128 + wr * 64 + i * 16 + r] * (1.f / 768.f) + 1e-6f);
    f32x4 acc[4][4], xr[4][4];
#pragma unroll
    for (int i = 0; i < 4; ++i)
#pragma unroll
      for (int j = 0; j < 4; ++j) xr[i][j] = __builtin_nontemporal_load((const f32x4*)(xin + ((size_t)mt_ * 128 + wr * 64 + i * 16 + r) * 2048 + nt_ * 128 + wc * 64 + j * 16 + quad * 4));
    gemm_tile<true>(MIX + (size_t)mt_ * 128 * LDX, LDX, W + (size_t)nt_ * 128 * LDX, LDX, 2048, smem, acc, 12, rsc);
#pragma unroll
    for (int i = 0; i < 4; ++i) {
      const size_t row = (size_t)mt_ * 128 + wr * 64 + i * 16 + r; float ss = 0.f;
#pragma unroll
      for (int j = 0; j < 4; ++j) {
        const int col = nt_ * 128 + wc * 64 + j * 16 + quad * 4;
        f32x4 v = xr[i][j] + acc[i][j];
        if (L == 1) __builtin_nontemporal_store(v, (f32x4*)(p.out + row * 2048 + col)); else *(f32x4*)(p.out + row * 2048 + col) = v;
        if (L == 0) {
          ss += v[0] * v[0] + v[1] * v[1] + v[2] * v[2] + v[3] * v[3];
          u32x2 wv; wv.x = pk2(v[0], v[1]); wv.y = pk2(v[2], v[3]);
          *(u32x2*)(XB + row * LDX + col) = wv;
        }
      }
      if (L == 0) { ss += __shfl_xor(ss, 16); ss += __shfl_xor(ss, 32); if (quad == 0 && rep == 0) atomicAdd(ssx + row, ss); }
    }
  }
}
template <int PH>
DI void run_phase(const P& p, unsigned char* smem, int* s_item, int rep) {
  int* ctr = (int*)(p.ws + WS_CTRL);
  if (PH == 0) {
    phase0(p, smem);
  } else {
    constexpr int L = (PH - 1) / 6, sub = (PH - 1) % 6;
    if (sub == 0) {
      phase1(p, L, smem);
    } else if (sub == 1) {
      constexpr int N_T40 = 64, N_DT = 64, N_CV = 512, N_KV = 768, N_Q = 576, N_SC = 512, N_ALL = N_T40 + N_KV + N_Q + N_CV + N_SC + N_DT;
      if (gridDim.x == 512) {
        const int b = blockIdx.x;
        if (b < 64) inproj_tile(p, L, b, 40, smem);
        else if (b < 128) dt_item(p, L, b - 64, smem);
        conv_item(p, L, b, smem);
        if (b < 128) kv_item(p, L, b / 12, b % 12, smem);
        else if (b < 384) { const int k0 = 128 + 2 * (b - 128); kv_item(p, L, k0 / 12, k0 % 12, smem); kv_item(p, L, (k0 + 1) / 12, (k0 + 1) % 12, smem); }
        else { const int k0 = 640 + (b - 384); kv_item(p, L, k0 / 12, k0 % 12, smem); }
        if (b < 64) { const int q0 = 512 + b; q_item(p, L, q0 / 9, q0 % 9, smem); }
        else if (b >= 128 && b < 384) { const int q0 = b - 128; q_item(p, L, q0 / 9, q0 % 9, smem); }
        else if (b >= 384) { const int q0 = 256 + 2 * (b - 384); q_item(p, L, q0 / 9, q0 % 9, smem); q_item(p, L, (q0 + 1) / 9, (q0 + 1) % 9, smem); }
        ssdconv_item(p, L, b);
      } else
      for (;;) {
        __syncthreads();
        if (threadIdx.x == 0) *s_item = atomicAdd(ctr + PH + 16 * rep, 1);
        __syncthreads();
        int it = *s_item;
        if (it >= N_ALL) break;
        if (it < N_T40) inproj_tile(p, L, it, 40, smem);
        else if ((it -= N_T40) < N_DT) dt_item(p, L, it, smem);
        else if ((it -= N_DT) < N_CV) conv_item(p, L, it, smem);
        else if ((it -= N_CV) < N_KV) kv_item(p, L, it / 12, it % 12, smem);
        else if ((it -= N_KV) < N_Q) q_item(p, L, it / 9, it % 9, smem);
        else ssdconv_item(p, L, it - N_Q);
      }
    } else if (sub == 2) {
      constexpr int N_AT = 576, N_SS = 768, N_PW = 256, N_ALL = N_AT + N_SS + N_PW;
      for (bool first = true;; first = false) {
        __syncthreads();
        if (threadIdx.x == 0) *s_item = first ? (int)blockIdx.x : (int)gridDim.x + atomicAdd(ctr + PH + 16 * rep, 1);
        __syncthreads();
        int it = *s_item;
        if (it >= N_ALL) break;
        if (it < N_AT) {
          const int xq = it & 7, jq = it >> 3, g3 = jq / 3, r3 = jq % 3;
          const int slot = (r3 < 2) ? 2 * g3 + r3 : 2 * g3 + (xq & 1), bh = (r3 < 2) ? xq : 8 + (xq >> 1); int qb, part;
          if (slot < 40) { const int g = slot / 5, rr = slot % 5, q2 = 15 - g;
            if (rr == 2) { qb = q2; part = -1; } else if (rr < 2) { qb = 2 * q2 + 1; part = rr; } else { qb = 2 * q2; part = rr - 3; } }
          else { qb = 47 - slot; part = -1; }
          const int nt = 2 * qb + 2;
          const int t_lo = (part == 1) ? qb + 1 : 0, t_hi = (part == 0) ? qb + 1 : nt;
          attn_item(p, L, bh / 6, bh % 6, qb, t_lo, t_hi, part, smem);
        }
        else if ((it -= N_AT) < N_SS) { const int h = it % 12, bc = it / 12; ssd_item(p, bc >> 5, bc & 31, h, smem); }
        else { it -= N_SS; pw_item(p, L, it >> 2, it & 3, smem); }
      }
    } else if (sub == 3) {
      for (int it = blockIdx.x; it < 384; it += gridDim.x) {
        if (it < 64 && threadIdx.x < 128) ((float*)(p.ws + WS_SSX))[it * 128 + threadIdx.x] = 0.f;
        if (it < 192) scan_item(p, it); else combine_item(p, it - 192);
      }
    } else if (sub == 4) {
      for (int it = blockIdx.x; it < 768; it += gridDim.x) { const int h = it % 12, bc = it / 12; yoff_item(p, L, bc >> 5, bc & 31, h, smem); }
    } else {
      phase6(p, L, smem, rep);
    }
  }
}
#define PROBE_REP_PH -1
#define RUN_PH(k) if (p.phase_lo <= (k) && (k) <= p.phase_hi) { for (int rep = 0; rep < ((k) == PROBE_REP_PH ? 2 : 1); ++rep) { run_phase<k>(p, smem, (int*)&sh_ctl[1], rep); \
    if (p.coop && ((k) < p.phase_hi || (rep == 0 && (k) == PROBE_REP_PH))) xcd_barrier(xb); } }
__global__ void __launch_bounds__(256, 2) mega(P p) {
  extern __shared__ __attribute__((aligned(16))) unsigned char smem[];
  __shared__ uint4 sh_ctl[2];
  cg::grid_group grid = cg::this_grid();
  if (threadIdx.x == 0) { sh_ctl[0] = make_uint4(0u, 0u, 0u, 0u); sh_ctl[1] = make_uint4(0u, 0u, 0u, 0u); }
  __syncthreads();
  XcdBarrier xb = xcd_barrier_post((unsigned*)(p.ws + WS_BAR), (volatile LAS unsigned*)&sh_ctl[0]);
  if (p.pad != 0) grid.sync();
  RUN_PH(0) RUN_PH(1) RUN_PH(2) RUN_PH(3) RUN_PH(4) RUN_PH(5) RUN_PH(6) RUN_PH(7) RUN_PH(8) RUN_PH(9) RUN_PH(10) RUN_PH(11) RUN_PH(12)
}

extern "C" void kernel_launch(void* const* d_in, const int* in_sizes, int n_in, void* d_out, int out_size, void* d_ws, size_t ws_size, hipStream_t stream) {
  static int grid_blocks = 0;
  if (grid_blocks == 0) {
    if (ws_size < WS_END) { fprintf(stderr, "kernel_launch: workspace too small: %zu < %zu\n", ws_size, (size_t)WS_END); grid_blocks = -1; return; }
    int dev = 0, cus = 0, per_cu = 0;
    hipGetDevice(&dev);
    hipDeviceGetAttribute(&cus, hipDeviceAttributeMultiprocessorCount, dev);
    hipFuncSetAttribute((const void*)mega, hipFuncAttributeMaxDynamicSharedMemorySize, SMEM_BYTES);
    hipOccupancyMaxActiveBlocksPerMultiprocessor(&per_cu, (const void*)mega, NT, SMEM_BYTES);
    if (per_cu < 1) per_cu = 1;
    if (per_cu > 2) per_cu = 2;
    grid_blocks = cus * per_cu;
    fprintf(stderr, "kernel_launch: cus %d per_cu %d grid %d ws %zu need %zu\n", cus, per_cu, grid_blocks, ws_size, (size_t)WS_END);
  }
  if (grid_blocks < 0) return;
  P p{};
  const float** f = (const float**)&p;
  for (int i = 0; i < 21; ++i) f[i] = (const float*)d_in[i];
  p.out = (float*)d_out; p.ws = (unsigned char*)d_ws;
  p.phase_lo = 0; p.phase_hi = 12; p.coop = 1; p.pad = 0;
  if (hipMemsetAsync(d_ws, 0, 16384, stream) != hipSuccess) { fprintf(stderr, "kernel_launch: hipMemsetAsync of the control words failed\n"); return; }
  void* args[] = {&p};
  hipError_t e = hipLaunchCooperativeKernel((const void*)mega, dim3(grid_blocks), dim3(NT), args, SMEM_BYTES, stream);
  if (e != hipSuccess) fprintf(stderr, "cooperative launch failed: %s (grid %d)\n", hipGetErrorString(e), grid_blocks);
}
```

```cpp
#include <hip/hip_runtime.h>
#include <hip/hip_cooperative_groups.h>
#include <cstdio>
#include <cstdint>
namespace cg = cooperative_groups;
#define DI __device__ __forceinline__
typedef unsigned short bf16_t;
typedef short bf16x8 __attribute__((ext_vector_type(8)));
typedef short bf16x4 __attribute__((ext_vector_type(4)));
typedef float f32x4 __attribute__((ext_vector_type(4)));
typedef unsigned u32x4 __attribute__((ext_vector_type(4)));
typedef unsigned u32x2 __attribute__((ext_vector_type(2)));
constexpr int T = 8192, SEQ = 4096, DM = 2048, NIN = 5196, LDU = 5248;
constexpr int LDX = 2112, LDQW = 576, LDKVW = 320, LDPW = 576, LDHC = 576, LDVT = 4160;
constexpr int NT = 256;
constexpr int U_CQ = 0, U_CKV = 512, U_KPE = 768, U_GMLA = 832, U_CA = 1600, U_CG = 2112, U_GCONV = 2624, U_Z = 3136, Z_HEAD = 688, U_XBC = 3824, U_DT = 5104, U_ZT = 5120;
DI int win_src_col(int n) { return n < 3824 ? n : (n < 5116 ? n + 80 : (n < 5120 ? -1 : (n < 5200 ? n - 1296 : -1))); }
constexpr int MIX_SSD = 0, MIX_MLA = 768, MIX_CONV = 1536;
constexpr int SMEM_BYTES = 77824;
constexpr int GEMM_SM = 4 * 128 * 72 * 2;
constexpr size_t al256(size_t x) { return (x + 255) & ~(size_t)255; }
constexpr size_t WS_CTRL = 0;
constexpr size_t WS_BAR = 1024;
constexpr size_t WS_WIN = 16384;
constexpr size_t SZ_WIN = (size_t)LDU * LDX * 2;
constexpr size_t WS_WQ = WS_WIN + 2 * SZ_WIN;
constexpr size_t SZ_WQ = (size_t)1152 * LDQW * 2;
constexpr size_t WS_WKV = WS_WQ + 2 * SZ_WQ;
constexpr size_t SZ_WKV = (size_t)1536 * LDKVW * 2;
constexpr size_t WS_WPW = WS_WKV + 2 * SZ_WKV;
constexpr size_t SZ_WPW = (size_t)512 * LDPW * 2;
constexpr size_t WS_WOUT = WS_WPW + 2 * SZ_WPW;
constexpr size_t SZ_WOUT = (size_t)2048 * LDX * 2;
constexpr size_t WS_COS = WS_WOUT + 2 * SZ_WOUT;
constexpr size_t WS_SIN = WS_COS + (size_t)4096 * 32 * 4;
constexpr size_t WS_XBA = WS_SIN + (size_t)4096 * 32 * 4;
constexpr size_t WS_XBB = WS_XBA + (size_t)T * LDX * 2;
constexpr size_t WS_HC = WS_XBB + (size_t)T * 768 * 4;
constexpr size_t WS_U = WS_XBB + (size_t)T * LDX * 2;
constexpr size_t WS_QRAW = WS_U + (size_t)T * LDU * 2;
constexpr size_t WS_KN = WS_QRAW + (size_t)T * 1152 * 2;
constexpr size_t WS_VT = WS_KN + (size_t)T * 1152 * 2;
constexpr size_t WS_XBCC = WS_VT + (size_t)12 * 128 * LDVT * 2;
constexpr size_t WS_STATES = WS_XBCC + (size_t)T * 1280 * 2;
constexpr size_t WS_DTRAW = WS_STATES + (size_t)T * 768 * 4;
constexpr size_t WS_DT = WS_DTRAW + (size_t)T * 12 * 4;
constexpr size_t WS_ACS = WS_DT + (size_t)T * 12 * 4;
constexpr size_t WS_SSX = WS_ACS + (size_t)T * 12 * 4;
constexpr size_t WS_SSS = WS_SSX + (size_t)T * 4;
constexpr size_t WS_PO = WS_SSS + (size_t)T * 4;
constexpr size_t WS_PML = WS_PO + (size_t)384 * 128 * 128 * 2;
constexpr size_t WS_END = WS_PML + (size_t)384 * 128 * 2 * 4;
static_assert(WS_END <= 340000000ull, "workspace too large");
static_assert((size_t)T * 768 * 4 + (size_t)T * LDHC * 2 <= (size_t)T * LDX * 2, "ydiag + hc alias inside xbB");
struct P {
  const float* x; const float* norm_g; const float* w_in; const float* q_a_norm; const float* w_q_b; const float* kv_a_norm;
  const float* w_kv_b; const float* q_norm; const float* k_norm; const float* conv_dw_w; const float* conv_dw_b; const float* conv_ln_g;
  const float* conv_ln_b; const float* conv_pw_w; const float* ssd_conv_w; const float* ssd_conv_b; const float* ssd_dt_bias;
  const float* ssd_A_log; const float* ssd_D; const float* ssd_norm_g; const float* w_out;
  float* out; unsigned char* ws;
  int phase_lo, phase_hi, coop, pad;
};
DI int otid() { int t = threadIdx.x; asm volatile("" : "+v"(t)); return t; }
DI float bf2f(bf16_t h) { return __uint_as_float(((unsigned)h) << 16); }
typedef __bf16 hbf2 __attribute__((ext_vector_type(2)));
typedef float f32x2 __attribute__((ext_vector_type(2)));
DI unsigned pk2(float a, float b) { f32x2 v = {a, b}; hbf2 r = __builtin_convertvector(v, hbf2); return __builtin_bit_cast(unsigned, r); }
DI bf16_t f2bf(float x) { return (bf16_t)(pk2(x, 0.f) & 0xffffu); }
DI float lo2f(unsigned w) { return __uint_as_float(w << 16); }
DI float hi2f(unsigned w) { return __uint_as_float(w & 0xffff0000u); }
DI float sigmoidf_(float x) { return __builtin_amdgcn_rcpf(1.f + __expf(-x)); }
DI float siluf_(float x) { return x * __builtin_amdgcn_rcpf(1.f + __expf(-x)); }
DI f32x4 mfma16(bf16x8 a, bf16x8 b, f32x4 c) { return __builtin_amdgcn_mfma_f32_16x16x32_bf16(a, b, c, 0, 0, 0); }
DI bf16x8 pack8(float a0, float a1, float a2, float a3, float a4, float a5, float a6, float a7) {
  u32x4 w; w.x = pk2(a0, a1); w.y = pk2(a2, a3); w.z = pk2(a4, a5); w.w = pk2(a6, a7); return __builtin_bit_cast(bf16x8, w);
}
DI void unpack8(u32x4 w, float* v) {
  v[0] = lo2f(w.x); v[1] = hi2f(w.x); v[2] = lo2f(w.y); v[3] = hi2f(w.y); v[4] = lo2f(w.z); v[5] = hi2f(w.z); v[6] = lo2f(w.w); v[7] = hi2f(w.w);
}

#define XB_TMO      128
#define XB_XCNT(j)  (256  + 64 * (j))
#define XB_XSUB(j)  (1280 + 64 * (j))
#define XB_XGEN(j)  (2304 + 64 * (j))
#define XB_TOP      3328
#define XB_TOPGEN   3392
#define XCD_BAR_WORDS 3456
#define XB_SPIN_CAP (1u << 20)
#define LAS __attribute__((address_space(3)))
DI unsigned xb_ld(unsigned* p) { return __hip_atomic_load(p, __ATOMIC_RELAXED, __HIP_MEMORY_SCOPE_AGENT); }
DI unsigned xb_add(unsigned* p, unsigned v) { return __hip_atomic_fetch_add(p, v, __ATOMIC_RELAXED, __HIP_MEMORY_SCOPE_AGENT); }
DI unsigned xb_xcc_id() { return (unsigned)__builtin_amdgcn_s_getreg((3 << 11) | 20) & 0xFu; }
#define XB_SPIN(cond, bar) do { unsigned _sp = 0; while (cond) { __builtin_amdgcn_s_sleep(1); \
    if ((++_sp & 255u) == 0u) { if (xb_ld(&(bar)[XB_TMO])) break; if (_sp > XB_SPIN_CAP) { atomicAdd(&(bar)[XB_TMO], 1u); break; } } } } while (0)
struct XcdBarrier { unsigned* bar; unsigned x; volatile LAS unsigned* st; };
DI XcdBarrier xcd_barrier_post(unsigned* bar, volatile LAS unsigned* st) {
  XcdBarrier b; b.bar = bar; b.x = xb_xcc_id(); b.st = st;
  if (threadIdx.x == 0) (void)xb_add(&bar[XB_XCNT(b.x)], 1u);
  return b;
}
DI void xcd_barrier_complete(unsigned* bar, unsigned x, unsigned& nloc, unsigned& nx) {
  const unsigned G = gridDim.x * gridDim.y * gridDim.z;
  unsigned sum, cnt, mine, sp = 0u;
  for (;;) {
    sum = 0u; cnt = 0u; mine = 0u;
#pragma unroll
    for (unsigned j = 0; j < 16; ++j) { const unsigned c = xb_ld(&bar[XB_XCNT(j)]); sum += c; cnt += (c > 0u) ? 1u : 0u; mine = (j == x) ? c : mine; }
    if (sum == G) break;
    __builtin_amdgcn_s_sleep(1);
    if ((++sp & 255u) == 0u) { if (xb_ld(&bar[XB_TMO])) break; if (sp > XB_SPIN_CAP) { atomicAdd(&bar[XB_TMO], 1u); break; } }
  }
  nloc = mine > 0u ? mine : 1u; nx = cnt > 0u ? cnt : 1u;
}
DI void xcd_barrier(const XcdBarrier& b) {
  asm volatile("s_waitcnt vmcnt(0)" ::: "memory");
  __syncthreads();
  if (threadIdx.x == 0) {
    unsigned* bar = b.bar;
    __builtin_amdgcn_s_waitcnt(0);
    unsigned nloc = b.st[0], nx = b.st[1];
    if (nloc == 0u) { xcd_barrier_complete(bar, b.x, nloc, nx); b.st[0] = nloc; b.st[1] = nx; }
    const unsigned old = xb_add(&bar[XB_XSUB(b.x)], 1u);
    const unsigned gen = old / nloc;
    if (old + 1u == (gen + 1u) * nloc) {
      __builtin_amdgcn_fence(__ATOMIC_RELEASE, "agent");
      asm volatile("s_waitcnt vmcnt(0)" ::: "memory");
      const unsigned og = xb_add(&bar[XB_TOP], 1u);
      const unsigned tg = og / nx;
      if (og + 1u == (tg + 1u) * nx) xb_add(&bar[XB_TOPGEN], 1u);
      else XB_SPIN(xb_ld(&bar[XB_TOPGEN]) == tg, bar);
      __builtin_amdgcn_fence(__ATOMIC_ACQUIRE, "agent");
      xb_add(&bar[XB_XGEN(b.x)], 1u);
      asm volatile("s_waitcnt vmcnt(0)" ::: "memory");
    } else {
      XB_SPIN(xb_ld(&bar[XB_XGEN(b.x)]) == gen, bar);
      __builtin_amdgcn_fence(__ATOMIC_ACQUIRE, "agent");
      asm volatile("s_waitcnt vmcnt(0)" ::: "memory");
    }
  }
  __syncthreads();
}

template <bool SCALE>
DI void gemm_tile(const bf16_t* A, long lda, const bf16_t* Bt, long ldb, int K, unsigned char* smem, f32x4 (&acc)[4][4], int ksplit, const float (&rscale)[4]) {
  const int tid = otid(), lane = tid & 63, wave = tid >> 6, wr = wave >> 1, wc = wave & 1, r = lane & 15, quad = lane >> 4;
  bf16_t* sA = (bf16_t*)smem;
  bf16_t* sB = (bf16_t*)smem + 2 * 128 * 64;
#pragma unroll
  for (int i = 0; i < 4; ++i)
#pragma unroll
    for (int j = 0; j < 4; ++j) acc[i][j] = (f32x4){0.f, 0.f, 0.f, 0.f};
  const int lrow = tid >> 3, lcc = ((tid & 7) ^ (lrow & 7)) * 8;
  const bf16_t* ga = A + (long)lrow * lda + lcc;
  const bf16_t* gb = Bt + (long)lrow * ldb + lcc;
  const int x0 = (quad ^ (r & 7)) * 8, x1 = ((quad ^ (r & 7)) ^ 4) * 8;
  const int nk = K >> 6;
#define G_DMA(bo, kt) { _Pragma("unroll") for (int i = 0; i < 4; ++i) {                                                                                   \
      __builtin_amdgcn_global_load_lds((const unsigned*)(ga + (long)(32 * i) * lda + (kt) * 64), (unsigned*)(sA + (bo) + i * 2048 + tid * 8), 16, 0, 0);    \
      __builtin_amdgcn_global_load_lds((const unsigned*)(gb + (long)(32 * i) * ldb + (kt) * 64), (unsigned*)(sB + (bo) + i * 2048 + tid * 8), 16, 0, 0); } }
#define G_COMPUTE(bo, kt)                                                                                   \
  {                                                                                                         \
    const bf16_t* cA = sA + (bo) + (wr * 64 + r) * 64;                                                      \
    const bf16_t* cB = sB + (bo) + (wc * 64 + r) * 64;                                                      \
    _Pragma("unroll") for (int ks = 0; ks < 2; ++ks) {                                                      \
      const int xo = ks ? x1 : x0;                                                                          \
      bf16x8 af[4], bfr[4];                                                                                 \
      _Pragma("unroll") for (int i = 0; i < 4; ++i) { af[i] = *(const bf16x8*)(cA + i * 16 * 64 + xo); bfr[i] = *(const bf16x8*)(cB + i * 16 * 64 + xo); } \
      _Pragma("unroll") for (int i = 0; i < 4; ++i)                                                         \
        _Pragma("unroll") for (int j = 0; j < 4; ++j) acc[i][j] = mfma16(bfr[j], af[i], acc[i][j]);         \
    }                                                                                                       \
    if (SCALE) { if ((kt) + 1 == ksplit) {                                                                  \
      _Pragma("unroll") for (int i = 0; i < 4; ++i)                                                         \
        _Pragma("unroll") for (int j = 0; j < 4; ++j) acc[i][j] *= rscale[i]; } }                           \
  }
  __syncthreads();
  G_DMA(0, 0)
  __syncthreads();
#pragma unroll 1
  for (int kt = 0; kt < nk; ++kt) {
    const int cur = (kt & 1) * 8192, nxt = cur ^ 8192;
    const int kl = (kt + 1 < nk) ? kt + 1 : nk - 1;
    G_DMA(nxt, kl)
    G_COMPUTE(cur, kt)
    __syncthreads();
  }
#define G_LOAD
#undef G_LOAD
#undef G_DMA
#undef G_COMPUTE
}

template <int W>
DI void rows_rstd(const bf16_t* base, long ld, float eps, float* rs) {
  const int tid = otid(), row = tid >> 1, half = tid & 1;
  const bf16_t* ptr = base + (long)row * ld + half * (W >> 1);
  u32x4 v[W / 16];
#pragma unroll
  for (int i = 0; i < W / 16; ++i) v[i] = *(const u32x4*)(ptr + i * 8);
  float ss = 0.f;
#pragma unroll
  for (int i = 0; i < W / 16; ++i) {
    float f[8]; unpack8(v[i], f);
#pragma unroll
    for (int e = 0; e < 8; ++e) ss += f[e] * f[e];
  }
  ss += __shfl_xor(ss, 1);
  if (!half) rs[row] = rsqrtf(ss / (float)W + eps);
}

struct TrArgs { const float* src; const float* gain; bf16_t* dst; int N, ksrc0, n0, ldd, kdst0, remap; };
DI void transpose_tile2(const TrArgs& a0, const TrArgs& a1, unsigned char* smem) {
  const int tid = otid();
  f32x4 v4[2][4]; float gn[2][4];
#pragma unroll
  for (int u = 0; u < 2; ++u) {
    const TrArgs& a = u ? a1 : a0;
#pragma unroll
    for (int i = 0; i < 4; ++i) {
      const int idx4 = tid + 256 * i, kk = idx4 >> 4, n = a.n0 + (idx4 & 15) * 4;
      const int sn = a.remap ? win_src_col(n) : (n < a.N ? n : -1);
      v4[u][i] = (sn >= 0) ? __builtin_nontemporal_load((const f32x4*)(a.src + (long)(a.ksrc0 + kk) * a.N + sn)) : (f32x4){0.f, 0.f, 0.f, 0.f};
      gn[u][i] = a.gain ? a.gain[kk] : 1.f;
    }
  }
  __syncthreads();
#pragma unroll
  for (int u = 0; u < 2; ++u) {
    float* t = (float*)smem + u * (64 * 65);
#pragma unroll
    for (int i = 0; i < 4; ++i) {
      const int idx4 = tid + 256 * i, kk = idx4 >> 4, nn = (idx4 & 15) * 4;
      t[kk * 65 + nn] = v4[u][i][0] * gn[u][i]; t[kk * 65 + nn + 1] = v4[u][i][1] * gn[u][i]; t[kk * 65 + nn + 2] = v4[u][i][2] * gn[u][i]; t[kk * 65 + nn + 3] = v4[u][i][3] * gn[u][i];
    }
  }
  __syncthreads();
  const int nn = tid >> 2, kc = (tid & 3) * 16;
#pragma unroll
  for (int u = 0; u < 2; ++u) {
    const TrArgs& a = u ? a1 : a0;
    const float* t = (const float*)smem + u * (64 * 65);
    float v[16];
#pragma unroll
    for (int j = 0; j < 16; ++j) v[j] = t[(kc + j) * 65 + nn];
    u32x4 w0, w1;
    w0.x = pk2(v[0], v[1]); w0.y = pk2(v[2], v[3]); w0.z = pk2(v[4], v[5]); w0.w = pk2(v[6], v[7]);
    w1.x = pk2(v[8], v[9]); w1.y = pk2(v[10], v[11]); w1.z = pk2(v[12], v[13]); w1.w = pk2(v[14], v[15]);
    bf16_t* d = a.dst + (long)(a.n0 + nn) * a.ldd + a.kdst0 + kc;
    *(u32x4*)d = w0; *(u32x4*)(d + 8) = w1;
  }
}

constexpr int T_WIN = 32 * 82, T_WQ = 8 * 18, T_WKV = 4 * 24, T_WPW = 8 * 8, T_WOUT = 32 * 32;
constexpr int TR_PER_L = T_WIN + T_WQ + T_WKV + T_WPW + T_WOUT;
DI TrArgs tr_decode(const P& p, int it) {
  unsigned char* ws = p.ws;
  const int L = it / TR_PER_L; int r = it % TR_PER_L;
  TrArgs a; a.remap = 0;
  if (r < T_WIN) {
    a.remap = 1;
    const int kt = r % 32, nt = r / 32;
    a.src = p.w_in + (size_t)L * 2048 * NIN; a.N = NIN; a.ksrc0 = kt * 64; a.n0 = nt * 64; a.gain = p.norm_g + L * 2048 + kt * 64; a.dst = (bf16_t*)(ws + WS_WIN + L * SZ_WIN); a.ldd = LDX; a.kdst0 = kt * 64;
  } else if ((r -= T_WIN) < T_WQ) {
    const int kt = r % 8, nt = r / 8;
    a.src = p.w_q_b + (size_t)L * 512 * 1152; a.N = 1152; a.ksrc0 = kt * 64; a.n0 = nt * 64; a.gain = p.q_a_norm + L * 512 + kt * 64; a.dst = (bf16_t*)(ws + WS_WQ + L * SZ_WQ); a.ldd = LDQW; a.kdst0 = kt * 64;
  } else if ((r -= T_WQ) < T_WKV) {
    const int kt = r % 4, nt = r / 4;
    a.src = p.w_kv_b + (size_t)L * 256 * 1536; a.N = 1536; a.ksrc0 = kt * 64; a.n0 = nt * 64; a.gain = p.kv_a_norm + L * 256 + kt * 64; a.dst = (bf16_t*)(ws + WS_WKV + L * SZ_WKV); a.ldd = LDKVW; a.kdst0 = kt * 64;
  } else if ((r -= T_WKV) < T_WPW) {
    const int kt = r % 8, nt = r / 8;
    a.src = p.conv_pw_w + (size_t)L * 512 * 512; a.N = 512; a.ksrc0 = kt * 64; a.n0 = nt * 64; a.gain = nullptr; a.dst = (bf16_t*)(ws + WS_WPW + L * SZ_WPW); a.ldd = LDPW; a.kdst0 = kt * 64;
  } else {
    r -= T_WPW;
    const int kt = r % 32, nt = r / 32, kd = kt * 64;
    a.src = p.w_out + (size_t)L * 2048 * 2048; a.N = 2048; a.ksrc0 = (kd < 768) ? kd + 1280 : kd - 768; a.n0 = nt * 64; a.gain = (kd < 768) ? p.ssd_norm_g + L * 768 + kd : nullptr;
    a.dst = (bf16_t*)(ws + WS_WOUT + L * SZ_WOUT); a.ldd = LDX; a.kdst0 = kd;
  }
  return a;
}

DI void phase0(const P& p, unsigned char* smem) {
  const int tid = otid();
  unsigned char* ws = p.ws;
  constexpr int N_TR = 2 * TR_PER_L, N_TR2 = N_TR / 2, N_X = T / 4, N_ROPE = 4096 * 32 / 256;
  static_assert(N_TR % 2 == 0, "pairs");
  for (int it = blockIdx.x; it < N_TR2 + N_X + N_ROPE; it += gridDim.x) {
    if (it < N_TR2) {
      const TrArgs a0 = tr_decode(p, 2 * it), a1 = tr_decode(p, 2 * it + 1);
      transpose_tile2(a0, a1, smem);
    } else if (it < N_TR2 + N_X) {
      const int row = (it - N_TR2) * 4 + (tid >> 6), lane = tid & 63;
      const float* xr = p.x + (size_t)row * 2048;
      bf16_t* xb = (bf16_t*)(ws + WS_XBA) + (size_t)row * LDX;
      float ss = 0.f;
#pragma unroll
      for (int i = 0; i < 8; ++i) {
        f32x4 v = __builtin_nontemporal_load((const f32x4*)(xr + lane * 4 + 256 * i));
        ss += v[0] * v[0] + v[1] * v[1] + v[2] * v[2] + v[3] * v[3];
        u32x2 w; w.x = pk2(v[0], v[1]); w.y = pk2(v[2], v[3]);
        *(u32x2*)(xb + lane * 4 + 256 * i) = w;
      }
#pragma unroll
      for (int o = 1; o < 64; o <<= 1) ss += __shfl_xor(ss, o);
      if (lane == 0) ((float*)(ws + WS_SSX))[row] = ss;
    } else {
      const int idx = (it - N_TR2 - N_X) * 256 + tid, s = idx >> 5, i = idx & 31;
      const float invf = (float)exp(-(double)i * (9.210340371976184 / 32.0));
      const float ang = (float)s * invf;
      double rev = (double)ang * 0.15915494309189535; rev -= floor(rev);
      ((float*)(ws + WS_COS))[idx] = __builtin_amdgcn_cosf((float)rev);
      ((float*)(ws + WS_SIN))[idx] = __builtin_amdgcn_sinf((float)rev);
    }
  }
}
DI void inproj_tile(const P& p, int L, int mt_, int nt_, unsigned char* smem) {
  unsigned char* ws = p.ws;
  const bf16_t* xb = (const bf16_t*)(ws + (L == 0 ? WS_XBA : WS_XBB));
  const bf16_t* W = (const bf16_t*)(ws + WS_WIN + L * SZ_WIN);
  bf16_t* U = (bf16_t*)(ws + WS_U);
  float* dtraw = (float*)(ws + WS_DTRAW);
  const float* ssx = (const float*)(ws + WS_SSX);
  const int tid = otid(), lane = tid & 63, wave = tid >> 6, wr = wave >> 1, wc = wave & 1, r = lane & 15, quad = lane >> 4;
  f32x4 acc[4][4]; const float dummy[4] = {1.f, 1.f, 1.f, 1.f};
  gemm_tile<false>(xb + (size_t)mt_ * 128 * LDX, LDX, W + (size_t)nt_ * 128 * LDX, LDX, 2048, smem, acc, 0, dummy);
#pragma unroll
  for (int i = 0; i < 4; ++i) {
    const int row = mt_ * 128 + wr * 64 + i * 16 + r;
    const float rs = rsqrtf(ssx[row] * (1.f / 2048.f) + 1e-6f);
#pragma unroll
    for (int j = 0; j < 4; ++j) {
      const int col = nt_ * 128 + wc * 64 + j * 16 + quad * 4;
      f32x4 v = acc[i][j] * rs;
      if (col >= U_DT && col < U_DT + 12) { *(f32x4*)(dtraw + (size_t)row * 12 + (col - U_DT)) = v; }
      else { u32x2 w; w.x = pk2(v[0], v[1]); w.y = pk2(v[2], v[3]); *(u32x2*)(U + (size_t)row * LDU + col) = w; }
    }
  }
}
DI void phase1(const P& p, int L, unsigned char* smem) {
  constexpr int NTILE = 64 * 40;
  for (int t = blockIdx.x; t < NTILE; t += gridDim.x) {
    const int mg = t / (16 * 40), rr = t % (16 * 40), mt_ = mg * 16 + rr / 40, nt_ = rr % 40;
    inproj_tile(p, L, mt_, nt_, smem);
  }
}

DI void kv_item(const P& p, int L, int mt_, int j, unsigned char* smem) {
  unsigned char* ws = p.ws;
  const bf16_t* U = (const bf16_t*)(ws + WS_U);
  const bf16_t* W = (const bf16_t*)(ws + WS_WKV + L * SZ_WKV);
  const int tid = otid(), lane = tid & 63, wave = tid >> 6, wr = wave >> 1, wc = wave & 1, r = lane & 15, quad = lane >> 4;
  const int tok0 = mt_ * 128, h = j >> 1, part = j & 1, b = tok0 >> 12, s0 = tok0 & 4095;
  float* rs_s = (float*)(smem + GEMM_SM);
  float* red = rs_s + 128;
  float* pe_ss = red + 256;
  float* rk_s = pe_ss + 128;
  const bf16_t* ckv = U + (size_t)tok0 * LDU + U_CKV;
  __syncthreads();
  rows_rstd<256>(ckv, LDU, 1e-6f, rs_s);
  f32x4 acc[4][4]; const float dummy[4] = {1.f, 1.f, 1.f, 1.f};
  if (part == 0) {
    gemm_tile<false>(ckv, LDU, W + (size_t)(h * 256) * LDKVW, LDKVW, 256, smem, acc, 0, dummy);
#pragma unroll
    for (int i = 0; i < 4; ++i) {
      const int row = wr * 64 + i * 16 + r; const float rsv = rs_s[row]; float s = 0.f;
#pragma unroll
      for (int jj = 0; jj < 4; ++jj) { acc[i][jj] *= rsv; s += acc[i][jj][0] * acc[i][jj][0] + acc[i][jj][1] * acc[i][jj][1] + acc[i][jj][2] * acc[i][jj][2] + acc[i][jj][3] * acc[i][jj][3]; }
      s += __shfl_xor(s, 16); s += __shfl_xor(s, 32);
      if (quad == 0) red[row * 2 + wc] = s;
    }
    {
      const int row = tid >> 1, half = tid & 1; const bf16_t* ptr = U + (size_t)(tok0 + row) * LDU + U_KPE + half * 32; float ss = 0.f;
#pragma unroll
      for (int i = 0; i < 4; ++i) { u32x4 v = *(const u32x4*)(ptr + i * 8); float f[8]; unpack8(v, f);
#pragma unroll
        for (int e = 0; e < 8; ++e) ss += f[e] * f[e]; }
      ss += __shfl_xor(ss, 1);
      if (!half) pe_ss[row] = ss;
    }
    __syncthreads();
    bf16_t* Kn = (bf16_t*)(ws + WS_KN) + ((size_t)(b * 6 + h) * 4096 + s0) * 192;
    const float* kn = p.k_norm + L * 192;
#pragma unroll
    for (int i = 0; i < 4; ++i) {
      const int row = wr * 64 + i * 16 + r;
      const float rk = rsqrtf((red[row * 2] + red[row * 2 + 1] + pe_ss[row]) * (1.f / 192.f) + 1e-6f);
      if (wc == 0 && quad == 0) rk_s[row] = rk;
#pragma unroll
      for (int jj = 0; jj < 4; ++jj) {
        const int col = wc * 64 + jj * 16 + quad * 4;
        const f32x4 g = *(const f32x4*)(kn + col);
        f32x4 v = acc[i][jj] * rk * g;
        u32x2 w; w.x = pk2(v[0], v[1]); w.y = pk2(v[2], v[3]);
        *(u32x2*)(Kn + (size_t)row * 192 + col) = w;
      }
    }
    __syncthreads();
    const float* cosT = (const float*)(ws + WS_COS); const float* sinT = (const float*)(ws + WS_SIN);
#pragma unroll 4
    for (int i = 0; i < 16; ++i) {
      const int idx = tid + 256 * i, row = idx >> 5, ii = idx & 31;
      const bf16_t* pe = U + (size_t)(tok0 + row) * LDU + U_KPE;
      const float rk = rk_s[row];
      const float x1 = bf2f(pe[ii]) * rk * kn[128 + ii], x2 = bf2f(pe[32 + ii]) * rk * kn[160 + ii];
      const float c = cosT[(s0 + row) * 32 + ii], sn = sinT[(s0 + row) * 32 + ii];
      Kn[(size_t)row * 192 + 128 + ii] = f2bf(x1 * c - x2 * sn);
      Kn[(size_t)row * 192 + 160 + ii] = f2bf(x2 * c + x1 * sn);
    }
  } else {
    gemm_tile<false>(W + (size_t)(h * 256 + 128) * LDKVW, LDKVW, ckv, LDU, 256, smem, acc, 0, dummy);
    bf16_t* Vt = (bf16_t*)(ws + WS_VT) + ((size_t)(b * 6 + h) * 128) * LDVT + s0;
#pragma unroll
    for (int i = 0; i < 4; ++i) {
      const int d = wr * 64 + i * 16 + r;
#pragma unroll
      for (int jj = 0; jj < 4; ++jj) {
        const int col = wc * 64 + jj * 16 + quad * 4;
        const f32x4 rv = *(const f32x4*)(rs_s + col);
        f32x4 v = acc[i][jj] * rv;
        u32x2 w; w.x = pk2(v[0], v[1]); w.y = pk2(v[2], v[3]);
        *(u32x2*)(Vt + (size_t)d * LDVT + col) = w;
      }
    }
  }
}
DI void q_item(const P& p, int L, int mt_, int nt_, unsigned char* smem) {
  unsigned char* ws = p.ws;
  const bf16_t* U = (const bf16_t*)(ws + WS_U);
  const bf16_t* W = (const bf16_t*)(ws + WS_WQ + L * SZ_WQ);
  bf16_t* Q = (bf16_t*)(ws + WS_QRAW);
  const int tid = otid(), lane = tid & 63, wave = tid >> 6, wr = wave >> 1, wc = wave & 1, r = lane & 15, quad = lane >> 4;
  const int tok0 = mt_ * 128;
  float* rs_s = (float*)(smem + GEMM_SM);
  __syncthreads();
  rows_rstd<512>(U + (size_t)tok0 * LDU + U_CQ, LDU, 1e-6f, rs_s);
  f32x4 acc[4][4]; const float dummy[4] = {1.f, 1.f, 1.f, 1.f};
  gemm_tile<false>(U + (size_t)tok0 * LDU + U_CQ, LDU, W + (size_t)nt_ * 128 * LDQW, LDQW, 512, smem, acc, 0, dummy);
#pragma unroll
  for (int i = 0; i < 4; ++i) {
    const int row = wr * 64 + i * 16 + r; const float rs = rs_s[row];
#pragma unroll
    for (int jj = 0; jj < 4; ++jj) {
      const int col = nt_ * 128 + wc * 64 + jj * 16 + quad * 4;
      f32x4 v = acc[i][jj] * rs;
      u32x2 w; w.x = pk2(v[0], v[1]); w.y = pk2(v[2], v[3]);
      *(u32x2*)(Q + (size_t)(tok0 + row) * 1152 + col) = w;
    }
  }
}
DI void conv_item(const P& p, int L, int it, unsigned char* smem) {
  unsigned char* ws = p.ws;
  const bf16_t* U = (const bf16_t*)(ws + WS_U);
  bf16_t* HC = (bf16_t*)(ws + (L == 0 ? WS_HC : WS_WIN));
  const int tid = otid(), lane = tid & 63, wave = tid >> 6;
  const int tok0 = it * 16, b = tok0 >> 12, s0 = tok0 & 4095;
  bf16_t* glu = (bf16_t*)smem;
  float* part = (float*)(smem + 46 * 512 * 2);
  __syncthreads();
#pragma unroll
  for (int pass = 0; pass < 2; ++pass) {
    u32x4 av[6], gv[6];
#pragma unroll
    for (int k = 0; k < 6; ++k) {
      const int c = tid + 256 * (pass * 6 + k), ri = c >> 6, cc = c & 63, sq = s0 - 30 + ri;
      av[k] = (u32x4){0u, 0u, 0u, 0u}; gv[k] = (u32x4){0u, 0u, 0u, 0u};
      if (c < 46 * 64 && sq >= 0) {
        const bf16_t* up = U + (size_t)(b * 4096 + sq) * LDU;
        av[k] = *(const u32x4*)(up + U_CA + cc * 8); gv[k] = *(const u32x4*)(up + U_CG + cc * 8);
      }
    }
#pragma unroll
    for (int k = 0; k < 6; ++k) {
      const int c = tid + 256 * (pass * 6 + k), ri = c >> 6, cc = c & 63;
      if (c < 46 * 64) {
        float fa[8], fg[8]; unpack8(av[k], fa); unpack8(gv[k], fg);
        u32x4 o;
        o.x = pk2(fa[0] * sigmoidf_(fg[0]), fa[1] * sigmoidf_(fg[1])); o.y = pk2(fa[2] * sigmoidf_(fg[2]), fa[3] * sigmoidf_(fg[3]));
        o.z = pk2(fa[4] * sigmoidf_(fg[4]), fa[5] * sigmoidf_(fg[5])); o.w = pk2(fa[6] * sigmoidf_(fg[6]), fa[7] * sigmoidf_(fg[7]));
        *(u32x4*)(glu + ri * 512 + cc * 8) = o;
      }
    }
  }
  __syncthreads();
  const int ch = tid * 2;
  const float* wdw = p.conv_dw_w + (size_t)L * 31 * 512 + ch;
  float w0[31], w1[31];
#pragma unroll
  for (int j = 0; j < 31; ++j) { w0[j] = wdw[j * 512]; w1[j] = wdw[j * 512 + 1]; }
  const float b0 = p.conv_dw_b[L * 512 + ch], b1 = p.conv_dw_b[L * 512 + ch + 1];
  float o0[16], o1[16];
#pragma unroll
  for (int tb = 0; tb < 4; ++tb) {
    unsigned v[34];
#pragma unroll
    for (int i = 0; i < 34; ++i) v[i] = *(const unsigned*)(glu + (tb * 4 + i) * 512 + ch);
#pragma unroll
    for (int tt = 0; tt < 4; ++tt) {
      float a0 = b0, a1 = b1;
#pragma unroll
      for (int j = 0; j < 31; ++j) { a0 += w0[j] * lo2f(v[tt + j]); a1 += w1[j] * hi2f(v[tt + j]); }
      o0[tb * 4 + tt] = a0; o1[tb * 4 + tt] = a1;
      float s1 = a0 + a1, s2 = a0 * a0 + a1 * a1;
#pragma unroll
      for (int o = 1; o < 64; o <<= 1) { s1 += __shfl_xor(s1, o); s2 += __shfl_xor(s2, o); }
      if (lane == 0) { part[((tb * 4 + tt) * 4 + wave) * 2] = s1; part[((tb * 4 + tt) * 4 + wave) * 2 + 1] = s2; }
    }
  }
  __syncthreads();
  const float g0 = p.conv_ln_g[L * 512 + ch], g1 = p.conv_ln_g[L * 512 + ch + 1], lb0 = p.conv_ln_b[L * 512 + ch], lb1 = p.conv_ln_b[L * 512 + ch + 1];
#pragma unroll
  for (int tk = 0; tk < 16; ++tk) {
    const float S1 = part[(tk * 4 + 0) * 2] + part[(tk * 4 + 1) * 2] + part[(tk * 4 + 2) * 2] + part[(tk * 4 + 3) * 2];
    const float S2 = part[(tk * 4 + 0) * 2 + 1] + part[(tk * 4 + 1) * 2 + 1] + part[(tk * 4 + 2) * 2 + 1] + part[(tk * 4 + 3) * 2 + 1];
    const float mean = S1 * (1.f / 512.f); float var = S2 * (1.f / 512.f) - mean * mean; var = var < 0.f ? 0.f : var;
    const float rstd = rsqrtf(var + 1e-5f);
    const float y0 = (o0[tk] - mean) * rstd * g0 + lb0, y1 = (o1[tk] - mean) * rstd * g1 + lb1;
    *(unsigned*)(HC + (size_t)(tok0 + tk) * LDHC + ch) = pk2(siluf_(y0), siluf_(y1));
  }
}
DI void ssdconv_item(const P& p, int L, int it) {
  unsigned char* ws = p.ws;
  const bf16_t* U = (const bf16_t*)(ws + WS_U);
  bf16_t* XC = (bf16_t*)(ws + WS_XBCC);
  const int tid = otid();
  const int tok0 = it * 16, b = tok0 >> 12, s0 = tok0 & 4095;
  const float* cw = p.ssd_conv_w + (size_t)L * 4 * 1280; const float* cb = p.ssd_conv_b + L * 1280;
#pragma unroll 1
  for (int c0 = tid; c0 < 16 * 160; c0 += 512) {
    u32x4 v[2][4];
#pragma unroll
    for (int u = 0; u < 2; ++u) {
      const int c = c0 + 256 * u, tk = c / 160, cc = c % 160, sq = s0 + tk;
#pragma unroll
      for (int j = 0; j < 4; ++j) {
        const int sp = sq - 3 + j;
        v[u][j] = (u32x4){0u, 0u, 0u, 0u};
        if (sp >= 0) v[u][j] = *(const u32x4*)(U + (size_t)(b * 4096 + sp) * LDU + U_XBC + cc * 8);
      }
    }
#pragma unroll
    for (int u = 0; u < 2; ++u) {
      const int c = c0 + 256 * u, tk = c / 160, cc = c % 160;
      float a[8];
      { f32x4 b0 = *(const f32x4*)(cb + cc * 8), b1 = *(const f32x4*)(cb + cc * 8 + 4); a[0] = b0[0]; a[1] = b0[1]; a[2] = b0[2]; a[3] = b0[3]; a[4] = b1[0]; a[5] = b1[1]; a[6] = b1[2]; a[7] = b1[3]; }
#pragma unroll
      for (int j = 0; j < 4; ++j) {
        float f[8]; unpack8(v[u][j], f);
        f32x4 w0 = *(const f32x4*)(cw + j * 1280 + cc * 8), w1 = *(const f32x4*)(cw + j * 1280 + cc * 8 + 4);
        a[0] += f[0] * w0[0]; a[1] += f[1] * w0[1]; a[2] += f[2] * w0[2]; a[3] += f[3] * w0[3];
        a[4] += f[4] * w1[0]; a[5] += f[5] * w1[1]; a[6] += f[6] * w1[2]; a[7] += f[7] * w1[3];
      }
      u32x4 o; o.x = pk2(siluf_(a[0]), siluf_(a[1])); o.y = pk2(siluf_(a[2]), siluf_(a[3])); o.z = pk2(siluf_(a[4]), siluf_(a[5])); o.w = pk2(siluf_(a[6]), siluf_(a[7]));
      *(u32x4*)(XC + (size_t)(tok0 + tk) * 1280 + cc * 8) = o;
    }
  }
}

DI void dt_item(const P& p, int L, int it, unsigned char* smem) {
  unsigned char* ws = p.ws;
  const float* dtraw = (const float*)(ws + WS_DTRAW);
  float* dtg = (float*)(ws + WS_DT); float* acs = (float*)(ws + WS_ACS);
  const int tid = otid(), tok0 = it * 128;
  float* a_s = (float*)smem;
  __syncthreads();
  for (int idx = tid; idx < 1536; idx += 256) {
    const int l = idx / 12, h = idx % 12;
    const float raw = dtraw[(size_t)(tok0 + l) * 12 + h] + p.ssd_dt_bias[L * 12 + h];
    const float dtv = fmaxf(raw, 0.f) + log1pf(expf(-fabsf(raw)));
    dtg[(size_t)(tok0 + l) * 12 + h] = dtv;
    a_s[h * 128 + l] = dtv * (-expf(p.ssd_A_log[L * 12 + h]));
  }
  __syncthreads();
  for (int idx = tid; idx < 1536; idx += 256) {
    const int l = idx & 127, h = idx >> 7;
    float cs = 0.f;
    for (int i = 0; i <= l; ++i) cs += a_s[h * 128 + i];
    acs[(size_t)(tok0 + l) * 12 + h] = cs;
  }
  if (tid < 128) ((float*)(ws + WS_SSS))[tok0 + tid] = 0.f;
}
DI void attn_item(const P& p, int L, int b, int h, int qb, int t_lo, int t_hi, int part, unsigned char* smem) {
  unsigned char* ws = p.ws;
  const bf16_t* U = (const bf16_t*)(ws + WS_U);
  const bf16_t* Qr = (const bf16_t*)(ws + WS_QRAW);
  const bf16_t* Kg = (const bf16_t*)(ws + WS_KN) + (size_t)(b * 6 + h) * 4096 * 192;
  const bf16_t* Vg = (const bf16_t*)(ws + WS_VT) + (size_t)(b * 6 + h) * 128 * LDVT;
  bf16_t* MIX = (bf16_t*)(ws + WS_XBA);
  const float* cosT = (const float*)(ws + WS_COS); const float* sinT = (const float*)(ws + WS_SIN);
  const int tid = otid(), lane = tid & 63, w = tid >> 6, r = lane & 15, quad = lane >> 4;
  bf16_t* Ks = (bf16_t*)smem;
  bf16_t* Vs = (bf16_t*)(smem + 2 * 64 * 192 * 2);
  const int qrow0 = qb * 128 + 32 * w;
  const float QSCALE = 0.07216878364870322f * 1.4426950408889634f;
  {
    bf16_t* Qs = (bf16_t*)smem;
    const int prow = tid >> 1, half = tid & 1, pos = qb * 128 + prow;
    const bf16_t* qp = Qr + (size_t)(b * 4096 + pos) * 1152 + h * 192 + half * 96;
    float ss = 0.f;
#pragma unroll
    for (int c = 0; c < 12; ++c) { const u32x4 raw = *(const u32x4*)(qp + c * 8); float f[8]; unpack8(raw, f);
#pragma unroll
      for (int e = 0; e < 8; ++e) ss += f[e] * f[e]; }
    ss += __shfl_xor(ss, 1);
    const float rq = rsqrtf(ss * (1.f / 192.f) + 1e-6f) * QSCALE;
    const float* qn = p.q_norm + L * 192 + half * 96;
    bf16_t* qs = Qs + prow * 200 + half * 96;
    const int nplain = half ? 4 : 12;
#pragma unroll 1
    for (int c = 0; c < nplain; ++c) {
      const u32x4 raw = *(const u32x4*)(qp + c * 8); float f[8]; unpack8(raw, f);
      const f32x4 g0 = *(const f32x4*)(qn + c * 8), g1 = *(const f32x4*)(qn + c * 8 + 4);
      u32x4 wv; wv.x = pk2(f[0] * rq * g0[0], f[1] * rq * g0[1]); wv.y = pk2(f[2] * rq * g0[2], f[3] * rq * g0[3]);
      wv.z = pk2(f[4] * rq * g1[0], f[5] * rq * g1[1]); wv.w = pk2(f[6] * rq * g1[2], f[7] * rq * g1[3]);
      *(u32x4*)(qs + c * 8) = wv;
    }
    if (half) {
#pragma unroll 1
      for (int c = 4; c < 8; ++c) {
        const u32x4 rawa = *(const u32x4*)(qp + c * 8), rawb = *(const u32x4*)(qp + (c + 4) * 8);
        float fa[8], fb[8]; unpack8(rawa, fa); unpack8(rawb, fb);
        float ra[8], rb[8];
#pragma unroll
        for (int e = 0; e < 8; ++e) {
          const float xa = fa[e] * rq * qn[c * 8 + e], xb = fb[e] * rq * qn[(c + 4) * 8 + e];
          const float cc = cosT[pos * 32 + (c - 4) * 8 + e], sn = sinT[pos * 32 + (c - 4) * 8 + e];
          ra[e] = xa * cc - xb * sn; rb[e] = xb * cc + xa * sn;
        }
        u32x4 wa, wb;
        wa.x = pk2(ra[0], ra[1]); wa.y = pk2(ra[2], ra[3]); wa.z = pk2(ra[4], ra[5]); wa.w = pk2(ra[6], ra[7]);
        wb.x = pk2(rb[0], rb[1]); wb.y = pk2(rb[2], rb[3]); wb.z = pk2(rb[4], rb[5]); wb.w = pk2(rb[6], rb[7]);
        *(u32x4*)(qs + c * 8) = wa; *(u32x4*)(qs + (c + 4) * 8) = wb;
      }
    }
  }
  __syncthreads();
  bf16x8 qf[2][6];
#pragma unroll
  for (int qt = 0; qt < 2; ++qt)
#pragma unroll
    for (int ks = 0; ks < 6; ++ks) qf[qt][ks] = *(const bf16x8*)((const bf16_t*)smem + (32 * w + 16 * qt + r) * 200 + ks * 32 + quad * 8);
  int kgo[6];
#pragma unroll
  for (int i = 0; i < 6; ++i) { const int c = i * 256 + tid, row = c / 24, pc = c % 24; kgo[i] = row * 192 + ((pc & 24) | ((pc & 7) ^ (row & 7))) * 8; }
  const int vkey = ((tid >> 3) & 7) ^ ((tid >> 6) & 1);
  const size_t vgo = (size_t)(tid >> 3) * LDVT + ((tid & 7) ^ vkey) * 8;
#define ATT_DMAK(buf, jt) { _Pragma("unroll") for (int i = 0; i < 6; ++i)                                                                   \
    __builtin_amdgcn_global_load_lds((const unsigned*)(Kg + (size_t)(jt) * 64 * 192 + kgo[i]), (unsigned*)(Ks + (buf) * 64 * 192 + (i * 256 + tid) * 8), 16, 0, 0); }
#define ATT_DMAV(jt) { _Pragma("unroll") for (int i = 0; i < 4; ++i)                                                                        \
    __builtin_amdgcn_global_load_lds((const unsigned*)(Vg + vgo + (size_t)i * 32 * LDVT + (jt) * 64), (unsigned*)(Vs + (i * 256 + tid) * 8), 16, 0, 0); }
  __syncthreads();
  ATT_DMAK(0, t_lo)
  float m[2] = {-INFINITY, -INFINITY}, l[2] = {0.f, 0.f};
  f32x4 o[8][2];
#pragma unroll
  for (int dt = 0; dt < 8; ++dt) { o[dt][0] = (f32x4){0.f, 0.f, 0.f, 0.f}; o[dt][1] = (f32x4){0.f, 0.f, 0.f, 0.f}; }
  for (int jt = t_lo; jt < t_hi; ++jt) {
    const int kcur = ((jt - t_lo) & 1) * 64 * 192;
    __syncthreads();
    ATT_DMAV(jt)
    { const int jn = (jt + 1 < t_hi) ? jt + 1 : jt; ATT_DMAK((((jt - t_lo) & 1) ^ 1), jn) }
    const int kstart = jt * 64;
    const bool active = (kstart <= qrow0 + 31);
    f32x4 s[4][2];
    if (active) {
#pragma unroll
      for (int kt = 0; kt < 4; ++kt) { s[kt][0] = (f32x4){0.f, 0.f, 0.f, 0.f}; s[kt][1] = (f32x4){0.f, 0.f, 0.f, 0.f}; }
      {
        const bf16_t* kbase = Ks + kcur + r * 192;
        const int kx0 = (quad ^ (r & 7)) * 8, kx1 = kx0 ^ 32;
        bf16x8 kf[2][4];
#pragma unroll
        for (int kt = 0; kt < 4; ++kt) kf[0][kt] = *(const bf16x8*)(kbase + kt * 16 * 192 + kx0);
#pragma unroll
        for (int ks = 0; ks < 6; ++ks) {
          if (ks < 5) {
#pragma unroll
            for (int kt = 0; kt < 4; ++kt) kf[(ks + 1) & 1][kt] = *(const bf16x8*)(kbase + kt * 16 * 192 + ((ks + 1) >> 1) * 64 + (((ks + 1) & 1) ? kx1 : kx0));
          }
#pragma unroll
          for (int kt = 0; kt < 4; ++kt) {
            s[kt][0] = mfma16(kf[ks & 1][kt], qf[0][ks], s[kt][0]);
            s[kt][1] = mfma16(kf[ks & 1][kt], qf[1][ks], s[kt][1]);
          }
          __builtin_amdgcn_sched_barrier(0);
        }
      }
      const bool need_mask = (kstart + 63 > qrow0);
#pragma unroll
      for (int qt = 0; qt < 2; ++qt) {
        const int qpos = qrow0 + 16 * qt + r;
        if (need_mask) {
#pragma unroll
          for (int kt = 0; kt < 4; ++kt)
#pragma unroll
            for (int t = 0; t < 4; ++t) if (kstart + kt * 16 + quad * 4 + t > qpos) s[kt][qt][t] = -INFINITY;
        }
        float mx = -INFINITY;
#pragma unroll
        for (int kt = 0; kt < 4; ++kt) mx = fmaxf(mx, fmaxf(fmaxf(s[kt][qt][0], s[kt][qt][1]), fmaxf(s[kt][qt][2], s[kt][qt][3])));
        mx = fmaxf(mx, __shfl_xor(mx, 16)); mx = fmaxf(mx, __shfl_xor(mx, 32));
        if (!__all(mx - m[qt] <= 8.f)) {
          const float mnew = fmaxf(m[qt], mx);
          const float alpha = __builtin_amdgcn_exp2f(m[qt] - mnew);
          m[qt] = mnew; l[qt] *= alpha;
#pragma unroll
          for (int dt = 0; dt < 8; ++dt) o[dt][qt] *= alpha;
        }
        const float mref = m[qt];
        float rsum = 0.f;
#pragma unroll
        for (int kt = 0; kt < 4; ++kt)
#pragma unroll
          for (int t = 0; t < 4; ++t) { const float pv = __builtin_amdgcn_exp2f(s[kt][qt][t] - mref); s[kt][qt][t] = pv; rsum += pv; }
        l[qt] += rsum;
      }
    }
    __syncthreads();
    if (active) {
      const int vkr = (r & 7) ^ ((r >> 3) & 1), vx8 = ((quad >> 1) ^ vkr) * 8, vq = (quad & 1) * 4;
#pragma unroll
      for (int k2 = 0; k2 < 2; ++k2) {
        const bf16x8 pf0 = pack8(s[2 * k2][0][0], s[2 * k2][0][1], s[2 * k2][0][2], s[2 * k2][0][3], s[2 * k2 + 1][0][0], s[2 * k2 + 1][0][1], s[2 * k2 + 1][0][2], s[2 * k2 + 1][0][3]);
        const bf16x8 pf1 = pack8(s[2 * k2][1][0], s[2 * k2][1][1], s[2 * k2][1][2], s[2 * k2][1][3], s[2 * k2 + 1][1][0], s[2 * k2 + 1][1][1], s[2 * k2 + 1][1][2], s[2 * k2 + 1][1][3]);
        const bf16_t* vb0 = Vs + r * 64 + (vx8 ^ (k2 * 32)) + vq;
        const bf16_t* vb1 = Vs + r * 64 + (vx8 ^ (k2 * 32 + 16)) + vq;
        bf16x4 va[2][2], vb[2][2];
#pragma unroll
        for (int u = 0; u < 2; ++u) { va[0][u] = *(const bf16x4*)(vb0 + u * 16 * 64); vb[0][u] = *(const bf16x4*)(vb1 + u * 16 * 64); }
#pragma unroll
        for (int d2 = 0; d2 < 4; ++d2) {
          if (d2 < 3) {
#pragma unroll
            for (int u = 0; u < 2; ++u) { va[(d2 + 1) & 1][u] = *(const bf16x4*)(vb0 + ((d2 + 1) * 2 + u) * 16 * 64); vb[(d2 + 1) & 1][u] = *(const bf16x4*)(vb1 + ((d2 + 1) * 2 + u) * 16 * 64); }
          }
#pragma unroll
          for (int u = 0; u < 2; ++u) {
            const bf16x8 vf = __builtin_shufflevector(va[d2 & 1][u], vb[d2 & 1][u], 0, 1, 2, 3, 4, 5, 6, 7);
            o[d2 * 2 + u][0] = mfma16(vf, pf0, o[d2 * 2 + u][0]);
            o[d2 * 2 + u][1] = mfma16(vf, pf1, o[d2 * 2 + u][1]);
          }
        }
      }
    }
  }
#undef ATT_DMAK
#undef ATT_DMAV
#pragma unroll
  for (int qt = 0; qt < 2; ++qt) {
    float lt = l[qt]; lt += __shfl_xor(lt, 16); lt += __shfl_xor(lt, 32);
    const float inv = 1.f / lt;
    if (part < 0) {
      const size_t tok = (size_t)b * 4096 + qrow0 + 16 * qt + r;
#pragma unroll
      for (int dt = 0; dt < 8; ++dt) {
        const int col = h * 128 + dt * 16 + quad * 4;
        const u32x2 g = *(const u32x2*)(U + tok * LDU + U_GMLA + col);
        f32x4 v = o[dt][qt] * inv;
        u32x2 wv; wv.x = pk2(v[0] * siluf_(lo2f(g.x)), v[1] * siluf_(hi2f(g.x))); wv.y = pk2(v[2] * siluf_(lo2f(g.y)), v[3] * siluf_(hi2f(g.y)));
        *(u32x2*)(MIX + tok * LDX + MIX_MLA + col) = wv;
      }
    } else {
      const size_t slot = ((size_t)(b * 6 + h) * 16 + (qb - 16)) * 2 + part;
      const int row = 32 * w + 16 * qt + r;
      bf16_t* po = (bf16_t*)(ws + WS_PO) + (slot * 128 + row) * 128;
#pragma unroll
      for (int dt = 0; dt < 8; ++dt) {
        f32x4 v = o[dt][qt] * inv;
        u32x2 wv; wv.x = pk2(v[0], v[1]); wv.y = pk2(v[2], v[3]);
        *(u32x2*)(po + dt * 16 + quad * 4) = wv;
      }
      if (quad == 0) { float* pml = (float*)(ws + WS_PML) + (slot * 128 + row) * 2; pml[0] = m[qt]; pml[1] = lt; }
    }
  }
}

DI void pw_item(const P& p, int L, int mt_, int nt_, unsigned char* smem) {
  unsigned char* ws = p.ws;
  const bf16_t* U = (const bf16_t*)(ws + WS_U);
  const bf16_t* HC = (const bf16_t*)(ws + (L == 0 ? WS_HC : WS_WIN));
  const bf16_t* W = (const bf16_t*)(ws + WS_WPW + L * SZ_WPW);
  bf16_t* MIX = (bf16_t*)(ws + WS_XBA);
  const int tid = otid(), lane = tid & 63, wave = tid >> 6, wr = wave >> 1, wc = wave & 1, r = lane & 15, quad = lane >> 4;
  f32x4 acc[4][4]; const float dummy[4] = {1.f, 1.f, 1.f, 1.f};
  gemm_tile<false>(HC + (size_t)mt_ * 128 * LDHC, LDHC, W + (size_t)nt_ * 128 * LDPW, LDPW, 512, smem, acc, 0, dummy);
#pragma unroll
  for (int i = 0; i < 4; ++i) {
    const size_t tok = (size_t)mt_ * 128 + wr * 64 + i * 16 + r;
#pragma unroll
    for (int jj = 0; jj < 4; ++jj) {
      const int col = nt_ * 128 + wc * 64 + jj * 16 + quad * 4;
      const u32x2 g = *(const u32x2*)(U + tok * LDU + U_GCONV + col);
      const f32x4 v = acc[i][jj];
      u32x2 wv; wv.x = pk2(v[0] * siluf_(lo2f(g.x)), v[1] * siluf_(hi2f(g.x))); wv.y = pk2(v[2] * siluf_(lo2f(g.y)), v[3] * siluf_(hi2f(g.y)));
      *(u32x2*)(MIX + tok * LDX + MIX_CONV + col) = wv;
    }
  }
}
DI void ssd_item(const P& p, int b, int c, int h, unsigned char* smem) {
  unsigned char* ws = p.ws;
  const bf16_t* XC = (const bf16_t*)(ws + WS_XBCC);
  const float* dtg = (const float*)(ws + WS_DT); const float* acsg = (const float*)(ws + WS_ACS);
  float* YD = (float*)(ws + WS_XBB);
  float* ST = (float*)(ws + WS_STATES);
  const int tid = otid(), lane = tid & 63, w = tid >> 6, r = lane & 15, quad = lane >> 4;
  const int g = h / 6; const size_t tok0 = (size_t)b * 4096 + c * 128;
  bf16_t* R0 = (bf16_t*)smem;
  bf16_t* R1 = (bf16_t*)(smem + 34816);
  float* acs_s = (float*)(smem + 69632);
  float* dt_s = acs_s + 128;
  __syncthreads();
  u32x4 braw[8], xraw[4];
#pragma unroll
  for (int i = 0; i < 8; ++i) {
    const int cidx = tid + 256 * i, row = cidx >> 4, cc = cidx & 15;
    *(u32x4*)(R0 + row * 136 + cc * 8) = *(const u32x4*)(XC + (tok0 + row) * 1280 + g * 128 + cc * 8 + 1024);
  }
#pragma unroll
  for (int i = 0; i < 8; ++i) { const int cidx = tid + 256 * i, lrow = cidx & 127, cc = cidx >> 7; braw[i] = *(const u32x4*)(XC + (tok0 + lrow) * 1280 + 768 + g * 128 + cc * 8); }
#pragma unroll
  for (int i = 0; i < 4; ++i) { const int cidx = tid + 256 * i, lrow = cidx & 127, cc = cidx >> 7; xraw[i] = *(const u32x4*)(XC + (tok0 + lrow) * 1280 + h * 64 + cc * 8); }
#pragma unroll
  for (int i = 0; i < 8; ++i) { const int cidx = tid + 256 * i, lrow = cidx & 127, cc = cidx >> 7; *(u32x4*)(R1 + lrow * 136 + cc * 8) = braw[i]; }
  if (tid < 128) { acs_s[tid] = acsg[(tok0 + tid) * 12 + h]; dt_s[tid] = dtg[(tok0 + tid) * 12 + h]; }
  __syncthreads();
  {
    f32x4 acc[2][8];
#pragma unroll
    for (int i = 0; i < 2; ++i)
#pragma unroll
      for (int j = 0; j < 8; ++j) acc[i][j] = (f32x4){0.f, 0.f, 0.f, 0.f};
#pragma unroll
    for (int ks = 0; ks < 4; ++ks) {
      bf16x8 cf[2];
#pragma unroll
      for (int i = 0; i < 2; ++i) cf[i] = *(const bf16x8*)(R0 + (32 * w + i * 16 + r) * 136 + ks * 32 + quad * 8);
#pragma unroll
      for (int j = 0; j < 8; ++j) {
        const bf16x8 bfr = *(const bf16x8*)(R1 + (j * 16 + r) * 136 + ks * 32 + quad * 8);
        acc[0][j] = mfma16(bfr, cf[0], acc[0][j]); acc[1][j] = mfma16(bfr, cf[1], acc[1][j]);
      }
    }
    __syncthreads();
#pragma unroll
    for (int i = 0; i < 2; ++i) {
      const int lrow = 32 * w + i * 16 + r; const float al = acs_s[lrow];
#pragma unroll
      for (int j = 0; j < 8; ++j) {
        const int s = j * 16 + quad * 4; float mv[4];
#pragma unroll
        for (int t = 0; t < 4; ++t) mv[t] = (s + t <= lrow) ? acc[i][j][t] * __expf(al - acs_s[s + t]) : 0.f;
        u32x2 wv; wv.x = pk2(mv[0], mv[1]); wv.y = pk2(mv[2], mv[3]);
        *(u32x2*)(R0 + lrow * 136 + s) = wv;
      }
    }
  }
  {
    const float alast = acs_s[127];
#pragma unroll
    for (int i = 0; i < 4; ++i) {
      const int cidx = tid + 256 * i, lrow = cidx & 127, cc = cidx >> 7;
      float f[8]; unpack8(xraw[i], f);
      const float d1 = dt_s[lrow], d2 = d1 * __expf(alast - acs_s[lrow]);
#pragma unroll
      for (int e = 0; e < 8; ++e) { R1[(cc * 8 + e) * 136 + lrow] = f2bf(f[e] * d1); R1[(64 + cc * 8 + e) * 136 + lrow] = f2bf(f[e] * d2); }
    }
  }
  __syncthreads();
  {
    f32x4 acc[2][4];
#pragma unroll
    for (int i = 0; i < 2; ++i)
#pragma unroll
      for (int j = 0; j < 4; ++j) acc[i][j] = (f32x4){0.f, 0.f, 0.f, 0.f};
#pragma unroll
    for (int ks = 0; ks < 4; ++ks) {
      bf16x8 mf[2];
#pragma unroll
      for (int i = 0; i < 2; ++i) mf[i] = *(const bf16x8*)(R0 + (32 * w + i * 16 + r) * 136 + ks * 32 + quad * 8);
#pragma unroll
      for (int j = 0; j < 4; ++j) {
        const bf16x8 xf = *(const bf16x8*)(R1 + (j * 16 + r) * 136 + ks * 32 + quad * 8);
        acc[0][j] = mfma16(xf, mf[0], acc[0][j]); acc[1][j] = mfma16(xf, mf[1], acc[1][j]);
      }
    }
#pragma unroll
    for (int i = 0; i < 2; ++i)
#pragma unroll
      for (int j = 0; j < 4; ++j) *(f32x4*)(YD + (tok0 + 32 * w + i * 16 + r) * 768 + h * 64 + j * 16 + quad * 4) = acc[i][j];
  }
  __syncthreads();
#pragma unroll
  for (int i = 0; i < 8; ++i) {
    const int cidx = tid + 256 * i, lrow = cidx & 127, cc = cidx >> 7;
    const bf16x8 v = __builtin_bit_cast(bf16x8, braw[i]);
#pragma unroll
    for (int e = 0; e < 8; ++e) R0[(cc * 8 + e) * 136 + lrow] = (bf16_t)v[e];
  }
  __syncthreads();
  {
    f32x4 acc[8];
#pragma unroll
    for (int j = 0; j < 8; ++j) acc[j] = (f32x4){0.f, 0.f, 0.f, 0.f};
#pragma unroll
    for (int ks = 0; ks < 4; ++ks) {
      const bf16x8 xf = *(const bf16x8*)(R1 + (64 + 16 * w + r) * 136 + ks * 32 + quad * 8);
#pragma unroll
      for (int j = 0; j < 8; ++j) {
        const bf16x8 bfr = *(const bf16x8*)(R0 + (j * 16 + r) * 136 + ks * 32 + quad * 8);
        acc[j] = mfma16(bfr, xf, acc[j]);
      }
    }
    float* dst = ST + ((((size_t)b * 32 + c) * 12 + h) * 64 + 16 * w + r) * 128;
#pragma unroll
    for (int j = 0; j < 8; ++j) *(f32x4*)(dst + j * 16 + quad * 4) = acc[j];
  }
}
DI void scan_item(const P& p, int it) {
  unsigned char* ws = p.ws;
  const float* ST = (const float*)(ws + WS_STATES); const float* acsg = (const float*)(ws + WS_ACS);
  bf16_t* PV = (bf16_t*)(ws + WS_QRAW);
  const int gi = it * 256 + otid(), n4 = gi & 31, pp = (gi >> 5) & 63, bh = gi >> 11, h = bh % 12, b = bh / 12;
  f32x4 st = (f32x4){0.f, 0.f, 0.f, 0.f};
  const size_t off0 = (((size_t)b * 32 * 12 + h) * 64 + pp) * 128 + n4 * 4;
  const float* ap = acsg + ((size_t)b * 4096 + 127) * 12 + h;
#pragma unroll 1
  for (int c0 = 0; c0 < 32; c0 += 16) {
    f32x4 sv[16]; float dc[16];
#pragma unroll
    for (int k = 0; k < 16; ++k) { sv[k] = *(const f32x4*)(ST + off0 + (size_t)(c0 + k) * (12 * 64 * 128)); dc[k] = ap[(size_t)(c0 + k) * 128 * 12]; }
#pragma unroll
    for (int k = 0; k < 16; ++k) {
      u32x2 wv; wv.x = pk2(st[0], st[1]); wv.y = pk2(st[2], st[3]);
      *(u32x2*)(PV + off0 + (size_t)(c0 + k) * (12 * 64 * 128)) = wv;
      st = st * __expf(dc[k]) + sv[k];
    }
  }
}

DI void combine_item(const P& p, int sidx) {
  unsigned char* ws = p.ws;
  const bf16_t* U = (const bf16_t*)(ws + WS_U);
  const bf16_t* PO = (const bf16_t*)(ws + WS_PO);
  const float* PML = (const float*)(ws + WS_PML);
  bf16_t* MIX = (bf16_t*)(ws + WS_XBA);
  const int tid = otid(), row = tid >> 1, half = tid & 1;
  const int bh = sidx >> 4, qb = 16 + (sidx & 15), b = bh / 6, h = bh % 6;
  const size_t tok = (size_t)b * 4096 + qb * 128 + row;
  const size_t s0 = (size_t)sidx * 2, s1 = s0 + 1;
  const float m0 = PML[(s0 * 128 + row) * 2], l0 = PML[(s0 * 128 + row) * 2 + 1], m1 = PML[(s1 * 128 + row) * 2], l1 = PML[(s1 * 128 + row) * 2 + 1];
  const float mm = fmaxf(m0, m1);
  float w0 = l0 * __builtin_amdgcn_exp2f(m0 - mm), w1 = l1 * __builtin_amdgcn_exp2f(m1 - mm);
  const float inv = 1.f / (w0 + w1); w0 *= inv; w1 *= inv;
  const bf16_t* p0 = PO + (s0 * 128 + row) * 128 + half * 64; const bf16_t* p1 = PO + (s1 * 128 + row) * 128 + half * 64;
  const bf16_t* gp = U + tok * LDU + U_GMLA + h * 128 + half * 64;
  bf16_t* mp = MIX + tok * LDX + MIX_MLA + h * 128 + half * 64;
  u32x4 a[8], c[8], g[8];
#pragma unroll
  for (int i = 0; i < 8; ++i) { a[i] = *(const u32x4*)(p0 + i * 8); c[i] = *(const u32x4*)(p1 + i * 8); g[i] = *(const u32x4*)(gp + i * 8); }
#pragma unroll
  for (int i = 0; i < 8; ++i) {
    float fa[8], fc[8], fg[8]; unpack8(a[i], fa); unpack8(c[i], fc); unpack8(g[i], fg);
    float o[8];
#pragma unroll
    for (int e = 0; e < 8; ++e) o[e] = (fa[e] * w0 + fc[e] * w1) * siluf_(fg[e]);
    u32x4 wv; wv.x = pk2(o[0], o[1]); wv.y = pk2(o[2], o[3]); wv.z = pk2(o[4], o[5]); wv.w = pk2(o[6], o[7]);
    *(u32x4*)(mp + i * 8) = wv;
  }
}

DI void yoff_item(const P& p, int L, int b, int c, int h, unsigned char* smem) {
  unsigned char* ws = p.ws;
  const bf16_t* U = (const bf16_t*)(ws + WS_U);
  const bf16_t* XC = (const bf16_t*)(ws + WS_XBCC);
  const bf16_t* PV = (const bf16_t*)(ws + WS_QRAW);
  const float* acsg = (const float*)(ws + WS_ACS);
  const float* YD = (const float*)(ws + WS_XBB);
  bf16_t* MIX = (bf16_t*)(ws + WS_XBA);
  float* sss = (float*)(ws + WS_SSS);
  const int tid = otid(), lane = tid & 63, w = tid >> 6, r = lane & 15, quad = lane >> 4;
  const int g = h / 6; const size_t tok0 = (size_t)b * 4096 + c * 128;
  bf16_t* R0 = (bf16_t*)smem;
  bf16_t* R1 = (bf16_t*)(smem + 34816);
  float* acs_s = (float*)(smem + 69632);
  f32x4 pyd[2][4]; u32x2 pxv[2][4], pzv[2][4];
#pragma unroll
  for (int i = 0; i < 2; ++i)
#pragma unroll
    for (int j = 0; j < 4; ++j) {
      const size_t tok = tok0 + 32 * w + i * 16 + r; const int col = h * 64 + j * 16 + quad * 4;
      pyd[i][j] = *(const f32x4*)(YD + tok * 768 + col);
      pxv[i][j] = *(const u32x2*)(XC + tok * 1280 + col);
      pzv[i][j] = *(const u32x2*)(U + tok * LDU + (col < Z_HEAD ? U_Z + col : U_ZT + (col - Z_HEAD)));
    }
  __syncthreads();
#pragma unroll
  for (int i = 0; i < 8; ++i) {
    const int cidx = tid + 256 * i, row = cidx >> 4, cc = cidx & 15;
    *(u32x4*)(R0 + row * 136 + cc * 8) = *(const u32x4*)(XC + (tok0 + row) * 1280 + 1024 + g * 128 + cc * 8);
  }
#pragma unroll
  for (int i = 0; i < 4; ++i) {
    const int cidx = tid + 256 * i, row = cidx >> 4, cc = cidx & 15;
    *(u32x4*)(R1 + row * 136 + cc * 8) = *(const u32x4*)(PV + ((((size_t)b * 32 + c) * 12 + h) * 64 + row) * 128 + cc * 8);
  }
  if (tid < 128) acs_s[tid] = acsg[(tok0 + tid) * 12 + h];
  __syncthreads();
  f32x4 acc[2][4];
#pragma unroll
  for (int i = 0; i < 2; ++i)
#pragma unroll
    for (int j = 0; j < 4; ++j) acc[i][j] = (f32x4){0.f, 0.f, 0.f, 0.f};
#pragma unroll
  for (int ks = 0; ks < 4; ++ks) {
    bf16x8 cf[2];
#pragma unroll
    for (int i = 0; i < 2; ++i) cf[i] = *(const bf16x8*)(R0 + (32 * w + i * 16 + r) * 136 + ks * 32 + quad * 8);
#pragma unroll
    for (int j = 0; j < 4; ++j) {
      const bf16x8 pf = *(const bf16x8*)(R1 + (j * 16 + r) * 136 + ks * 32 + quad * 8);
      acc[0][j] = mfma16(pf, cf[0], acc[0][j]); acc[1][j] = mfma16(pf, cf[1], acc[1][j]);
    }
  }
  const float Dh = p.ssd_D[L * 12 + h];
#pragma unroll
  for (int i = 0; i < 2; ++i) {
    const int lrow = 32 * w + i * 16 + r; const size_t tok = tok0 + lrow; const float e = __expf(acs_s[lrow]);
    float ss = 0.f;
#pragma unroll
    for (int j = 0; j < 4; ++j) {
      const int col = h * 64 + j * 16 + quad * 4;
      const f32x4 yd = pyd[i][j]; const u32x2 xv = pxv[i][j]; const u32x2 zv = pzv[i][j];
      const float y0 = acc[i][j][0] * e + yd[0] + Dh * lo2f(xv.x), y1 = acc[i][j][1] * e + yd[1] + Dh * hi2f(xv.x);
      const float y2 = acc[i][j][2] * e + yd[2] + Dh * lo2f(xv.y), y3 = acc[i][j][3] * e + yd[3] + Dh * hi2f(xv.y);
      const float g0 = y0 * siluf_(lo2f(zv.x)), g1 = y1 * siluf_(hi2f(zv.x)), g2 = y2 * siluf_(lo2f(zv.y)), g3 = y3 * siluf_(hi2f(zv.y));
      ss += g0 * g0 + g1 * g1 + g2 * g2 + g3 * g3;
      u32x2 wv; wv.x = pk2(g0, g1); wv.y = pk2(g2, g3);
      *(u32x2*)(MIX + tok * LDX + MIX_SSD + col) = wv;
    }
    ss += __shfl_xor(ss, 16); ss += __shfl_xor(ss, 32);
    if (quad == 0) atomicAdd(sss + tok, ss);
  }
}

DI void phase6(const P& p, int L, unsigned char* smem, int rep) {
  unsigned char* ws = p.ws;
  const bf16_t* MIX = (const bf16_t*)(ws + WS_XBA);
  const bf16_t* W = (const bf16_t*)(ws + WS_WOUT + L * SZ_WOUT);
  const float* sss = (const float*)(ws + WS_SSS);
  float* ssx = (float*)(ws + WS_SSX);
  bf16_t* XB = (bf16_t*)(ws + WS_XBB);
  const float* xin = (L == 0) ? p.x : (const float*)p.out;
  const int tid = otid(), lane = tid & 63, wave = tid >> 6, wr = wave >> 1, wc = wave & 1, r = lane & 15, quad = lane >> 4;
  constexpr int NTILE = 64 * 16;
  for (int t = blockIdx.x; t < NTILE; t += gridDim.x) {
    const int mt_ = t >> 4, nt_ = t & 15;
    float rsc[4];
#pragma unroll
    for (int i = 0; i < 4; ++i) rsc[i] = rsqrtf(sss[mt_ * 128 + wr * 64 + i * 16 + r] * (1.f / 768.f) + 1e-6f);
    f32x4 acc[4][4], xr[4][4];
#pragma unroll
    for (int i = 0; i < 4; ++i)
#pragma unroll
      for (int j = 0; j < 4; ++j) xr[i][j] = __builtin_nontemporal_load((const f32x4*)(xin + ((size_t)mt_ * 128 + wr * 64 + i * 16 + r) * 2048 + nt_ * 128 + wc * 64 + j * 16 + quad * 4));
    gemm_tile<true>(MIX + (size_t)mt_ * 128 * LDX, LDX, W + (size_t)nt_ * 128 * LDX, LDX, 2048, smem, acc, 12, rsc);
#pragma unroll
    for (int i = 0; i < 4; ++i) {
      const size_t row = (size_t)mt_ * 128 + wr * 64 + i * 16 + r; float ss = 0.f;
#pragma unroll
      for (int j = 0; j < 4; ++j) {
        const int col = nt_ * 128 + wc * 64 + j * 16 + quad * 4;
        f32x4 v = xr[i][j] + acc[i][j];
        if (L == 1) __builtin_nontemporal_store(v, (f32x4*)(p.out + row * 2048 + col)); else *(f32x4*)(p.out + row * 2048 + col) = v;
        if (L == 0) {
          ss += v[0] * v[0] + v[1] * v[1] + v[2] * v[2] + v[3] * v[3];
          u32x2 wv; wv.x = pk2(v[0], v[1]); wv.y = pk2(v[2], v[3]);
          *(u32x2*)(XB + row * LDX + col) = wv;
        }
      }
      if (L == 0) { ss += __shfl_xor(ss, 16); ss += __shfl_xor(ss, 32); if (quad == 0 && rep == 0) atomicAdd(ssx + row, ss); }
    }
  }
}
template <int PH>
DI void run_phase(const P& p, unsigned char* smem, int* s_item, int rep) {
  int* ctr = (int*)(p.ws + WS_CTRL);
  if (PH == 0) {
    phase0(p, smem);
  } else {
    constexpr int L = (PH - 1) / 6, sub = (PH - 1) % 6;
    if (sub == 0) {
      phase1(p, L, smem);
    } else if (sub == 1) {
      constexpr int N_T40 = 64, N_DT = 64, N_CV = 512, N_KV = 768, N_Q = 576, N_SC = 512, N_ALL = N_T40 + N_KV + N_Q + N_CV + N_SC + N_DT;
      if (gridDim.x == 512) {
        const int b = blockIdx.x;
        if (b < 64) inproj_tile(p, L, b, 40, smem);
        else if (b < 128) dt_item(p, L, b - 64, smem);
        conv_item(p, L, b, smem);
        if (b < 128) kv_item(p, L, b / 12, b % 12, smem);
        else if (b < 384) { const int k0 = 128 + 2 * (b - 128); kv_item(p, L, k0 / 12, k0 % 12, smem); kv_item(p, L, (k0 + 1) / 12, (k0 + 1) % 12, smem); }
        else { const int k0 = 640 + (b - 384); kv_item(p, L, k0 / 12, k0 % 12, smem); }
        if (b < 64) { const int q0 = 512 + b; q_item(p, L, q0 / 9, q0 % 9, smem); }
        else if (b >= 128 && b < 384) { const int q0 = b - 128; q_item(p, L, q0 / 9, q0 % 9, smem); }
        else if (b >= 384) { const int q0 = 256 + 2 * (b - 384); q_item(p, L, q0 / 9, q0 % 9, smem); q_item(p, L, (q0 + 1) / 9, (q0 + 1) % 9, smem); }
        ssdconv_item(p, L, b);
      } else
      for (;;) {
        __syncthreads();
        if (threadIdx.x == 0) *s_item = atomicAdd(ctr + PH + 16 * rep, 1);
        __syncthreads();
        int it = *s_item;
        if (it >= N_ALL) break;
        if (it < N_T40) inproj_tile(p, L, it, 40, smem);
        else if ((it -= N_T40) < N_DT) dt_item(p, L, it, smem);
        else if ((it -= N_DT) < N_CV) conv_item(p, L, it, smem);
        else if ((it -= N_CV) < N_KV) kv_item(p, L, it / 12, it % 12, smem);
        else if ((it -= N_KV) < N_Q) q_item(p, L, it / 9, it % 9, smem);
        else ssdconv_item(p, L, it - N_Q);
      }
    } else if (sub == 2) {
      constexpr int N_AT = 576, N_SS = 768, N_PW = 256, N_ALL = N_AT + N_SS + N_PW;
      for (bool first = true;; first = false) {
        __syncthreads();
        if (threadIdx.x == 0) *s_item = first ? (int)blockIdx.x : (int)gridDim.x + atomicAdd(ctr + PH + 16 * rep, 1);
        __syncthreads();
        int it = *s_item;
        if (it >= N_ALL) break;
        if (it < N_AT) {
          const int xq = it & 7, jq = it >> 3, g3 = jq / 3, r3 = jq % 3;
          const int slot = (r3 < 2) ? 2 * g3 + r3 : 2 * g3 + (xq & 1), bh = (r3 < 2) ? xq : 8 + (xq >> 1); int qb, part;
          if (slot < 40) { const int g = slot / 5, rr = slot % 5, q2 = 15 - g;
            if (rr == 2) { qb = q2; part = -1; } else if (rr < 2) { qb = 2 * q2 + 1; part = rr; } else { qb = 2 * q2; part = rr - 3; } }
          else { qb = 47 - slot; part = -1; }
          const int nt = 2 * qb + 2;
          const int t_lo = (part == 1) ? qb + 1 : 0, t_hi = (part == 0) ? qb + 1 : nt;
          attn_item(p, L, bh / 6, bh % 6, qb, t_lo, t_hi, part, smem);
        }
        else if ((it -= N_AT) < N_SS) { const int h = it % 12, bc = it / 12; ssd_item(p, bc >> 5, bc & 31, h, smem); }
        else { it -= N_SS; pw_item(p, L, it >> 2, it & 3, smem); }
      }
    } else if (sub == 3) {
      for (int it = blockIdx.x; it < 384; it += gridDim.x) {
        if (it < 64 && threadIdx.x < 128) ((float*)(p.ws + WS_SSX))[it * 128 + threadIdx.x] = 0.f;
        if (it < 192) scan_item(p, it); else combine_item(p, it - 192);
      }
    } else if (sub == 4) {
      for (int it = blockIdx.x; it < 768; it += gridDim.x) { const int h = it % 12, bc = it / 12; yoff_item(p, L, bc >> 5, bc & 31, h, smem); }
    } else {
      phase6(p, L, smem, rep);
    }
  }
}
#define PROBE_REP_PH -1
#define RUN_PH(k) if (p.phase_lo <= (k) && (k) <= p.phase_hi) { for (int rep = 0; rep < ((k) == PROBE_REP_PH ? 2 : 1); ++rep) { run_phase<k>(p, smem, (int*)&sh_ctl[1], rep); \
    if (p.coop && ((k) < p.phase_hi || (rep == 0 && (k) == PROBE_REP_PH))) xcd_barrier(xb); } }
__global__ void __launch_bounds__(256, 2) mega(P p) {
  extern __shared__ __attribute__((aligned(16))) unsigned char smem[];
  __shared__ uint4 sh_ctl[2];
  cg::grid_group grid = cg::this_grid();
  if (threadIdx.x == 0) { sh_ctl[0] = make_uint4(0u, 0u, 0u, 0u); sh_ctl[1] = make_uint4(0u, 0u, 0u, 0u); }
  __syncthreads();
  XcdBarrier xb = xcd_barrier_post((unsigned*)(p.ws + WS_BAR), (volatile LAS unsigned*)&sh_ctl[0]);
  if (p.pad != 0) grid.sync();
  RUN_PH(0) RUN_PH(1) RUN_PH(2) RUN_PH(3) RUN_PH(4) RUN_PH(5) RUN_PH(6) RUN_PH(7) RUN_PH(8) RUN_PH(9) RUN_PH(10) RUN_PH(11) RUN_PH(12)
}

extern "C" void kernel_launch(void* const* d_in, const int* in_sizes, int n_in, void* d_out, int out_size, void* d_ws, size_t ws_size, hipStream_t stream) {
  static int grid_blocks = 0;
  if (grid_blocks == 0) {
    if (ws_size < WS_END) { fprintf(stderr, "kernel_launch: workspace too small: %zu < %zu\n", ws_size, (size_t)WS_END); grid_blocks = -1; return; }
    int dev = 0, cus = 0, per_cu = 0;
    hipGetDevice(&dev);
    hipDeviceGetAttribute(&cus, hipDeviceAttributeMultiprocessorCount, dev);
    hipFuncSetAttribute((const void*)mega, hipFuncAttributeMaxDynamicSharedMemorySize, SMEM_BYTES);
    hipOccupancyMaxActiveBlocksPerMultiprocessor(&per_cu, (const void*)mega, NT, SMEM_BYTES);
    if (per_cu < 1) per_cu = 1;
    if (per_cu > 2) per_cu = 2;
    grid_blocks = cus * per_cu;
    fprintf(stderr, "kernel_launch: cus %d per_cu %d grid %d ws %zu need %zu\n", cus, per_cu, grid_blocks, ws_size, (size_t)WS_END);
  }
  if (grid_blocks < 0) return;
  P p{};
  const float** f = (const float**)&p;
  for (int i = 0; i < 21; ++i) f[i] = (const float*)d_in[i];
  p.out = (float*)d_out; p.ws = (unsigned char*)d_ws;
  p.phase_lo = 0; p.phase_hi = 12; p.coop = 1; p.pad = 0;
  if (hipMemsetAsync(d_ws, 0, 16384, stream) != hipSuccess) { fprintf(stderr, "kernel_launch: hipMemsetAsync of the control words failed\n"); return; }
  void* args[] = {&p};
  hipError_t e = hipLaunchCooperativeKernel((const void*)mega, dim3(grid_blocks), dim3(NT), args, SMEM_BYTES, stream);
  if (e != hipSuccess) fprintf(stderr, "cooperative launch failed: %s (grid %d)\n", hipGetErrorString(e), grid_blocks);
}
```

```cpp
#include <hip/hip_runtime.h>
#include <hip/hip_cooperative_groups.h>
#include <cstdio>
#include <cstdint>
namespace cg = cooperative_groups;
#define DI __device__ __forceinline__
typedef unsigned short bf16_t;
typedef short bf16x8 __attribute__((ext_vector_type(8)));
typedef short bf16x4 __attribute__((ext_vector_type(4)));
typedef float f32x4 __attribute__((ext_vector_type(4)));
typedef unsigned u32x4 __attribute__((ext_vector_type(4)));
typedef unsigned u32x2 __attribute__((ext_vector_type(2)));
constexpr int T = 8192, SEQ = 4096, DM = 2048, NIN = 5196, LDU = 5248;
constexpr int LDX = 2112, LDQW = 576, LDKVW = 320, LDPW = 576, LDHC = 576, LDVT = 4160;
constexpr int NT = 256;
constexpr int U_CQ = 0, U_CKV = 512, U_KPE = 768, U_GMLA = 832, U_CA = 1600, U_CG = 2112, U_GCONV = 2624, U_Z = 3136, Z_HEAD = 688, U_XBC = 3824, U_DT = 5104, U_ZT = 5120;
DI int win_src_col(int n) { return n < 3824 ? n : (n < 5116 ? n + 80 : (n < 5120 ? -1 : (n < 5200 ? n - 1296 : -1))); }
constexpr int MIX_SSD = 0, MIX_MLA = 768, MIX_CONV = 1536;
constexpr int SMEM_BYTES = 77824;
constexpr int GEMM_SM = 4 * 128 * 72 * 2;
constexpr size_t al256(size_t x) { return (x + 255) & ~(size_t)255; }
constexpr size_t WS_CTRL = 0;
constexpr size_t WS_BAR = 1024;
constexpr size_t WS_WIN = 16384;
constexpr size_t SZ_WIN = (size_t)LDU * LDX * 2;
constexpr size_t WS_WQ = WS_WIN + 2 * SZ_WIN;
constexpr size_t SZ_WQ = (size_t)1152 * LDQW * 2;
constexpr size_t WS_WKV = WS_WQ + 2 * SZ_WQ;
constexpr size_t SZ_WKV = (size_t)1536 * LDKVW * 2;
constexpr size_t WS_WPW = WS_WKV + 2 * SZ_WKV;
constexpr size_t SZ_WPW = (size_t)512 * LDPW * 2;
constexpr size_t WS_WOUT = WS_WPW + 2 * SZ_WPW;
constexpr size_t SZ_WOUT = (size_t)2048 * LDX * 2;
constexpr size_t WS_COS = WS_WOUT + 2 * SZ_WOUT;
constexpr size_t WS_SIN = WS_COS + (size_t)4096 * 32 * 4;
constexpr size_t WS_XBA = WS_SIN + (size_t)4096 * 32 * 4;
constexpr size_t WS_XBB = WS_XBA + (size_t)T * LDX * 2;
constexpr size_t WS_HC = WS_XBB + (size_t)T * 768 * 4;
constexpr size_t WS_U = WS_XBB + (size_t)T * LDX * 2;
constexpr size_t WS_QRAW = WS_U + (size_t)T * LDU * 2;
constexpr size_t WS_KN = WS_QRAW + (size_t)T * 1152 * 2;
constexpr size_t WS_VT = WS_KN + (size_t)T * 1152 * 2;
constexpr size_t WS_XBCC = WS_VT + (size_t)12 * 128 * LDVT * 2;
constexpr size_t WS_STATES = WS_XBCC + (size_t)T * 1280 * 2;
constexpr size_t WS_DTRAW = WS_STATES + (size_t)T * 768 * 4;
constexpr size_t WS_DT = WS_DTRAW + (size_t)T * 12 * 4;
constexpr size_t WS_ACS = WS_DT + (size_t)T * 12 * 4;
constexpr size_t WS_SSX = WS_ACS + (size_t)T * 12 * 4;
constexpr size_t WS_SSS = WS_SSX + (size_t)T * 4;
constexpr size_t WS_PO = WS_SSS + (size_t)T * 4;
constexpr size_t WS_PML = WS_PO + (size_t)384 * 128 * 128 * 2;
constexpr size_t WS_END = WS_PML + (size_t)384 * 128 * 2 * 4;
static_assert(WS_END <= 340000000ull, "workspace too large");
static_assert((size_t)T * 768 * 4 + (size_t)T * LDHC * 2 <= (size_t)T * LDX * 2, "ydiag + hc alias inside xbB");
struct P {
  const float* x; const float* norm_g; const float* w_in; const float* q_a_norm; const float* w_q_b; const float* kv_a_norm;
  const float* w_kv_b; const float* q_norm; const float* k_norm; const float* conv_dw_w; const float* conv_dw_b; const float* conv_ln_g;
  const float* conv_ln_b; const float* conv_pw_w; const float* ssd_conv_w; const float* ssd_conv_b; const float* ssd_dt_bias;
  const float* ssd_A_log; const float* ssd_D; const float* ssd_norm_g; const float* w_out;
  float* out; unsigned char* ws;
  int phase_lo, phase_hi, coop, pad;
};
DI int otid() { int t = threadIdx.x; asm volatile("" : "+v"(t)); return t; }
DI float bf2f(bf16_t h) { return __uint_as_float(((unsigned)h) << 16); }
typedef __bf16 hbf2 __attribute__((ext_vector_type(2)));
typedef float f32x2 __attribute__((ext_vector_type(2)));
DI unsigned pk2(float a, float b) { f32x2 v = {a, b}; hbf2 r = __builtin_convertvector(v, hbf2); return __builtin_bit_cast(unsigned, r); }
DI bf16_t f2bf(float x) { return (bf16_t)(pk2(x, 0.f) & 0xffffu); }
DI float lo2f(unsigned w) { return __uint_as_float(w << 16); }
DI float hi2f(unsigned w) { return __uint_as_float(w & 0xffff0000u); }
DI float sigmoidf_(float x) { return __builtin_amdgcn_rcpf(1.f + __expf(-x)); }
DI float siluf_(float x) { return x * __builtin_amdgcn_rcpf(1.f + __expf(-x)); }
DI float xmax16(float x) { auto rr = __builtin_amdgcn_permlane16_swap(__float_as_uint(x), __float_as_uint(x), false, false); return fmaxf(__uint_as_float(rr[0]), __uint_as_float(rr[1])); }
DI float xmax32(float x) { auto rr = __builtin_amdgcn_permlane32_swap(__float_as_uint(x), __float_as_uint(x), false, false); return fmaxf(__uint_as_float(rr[0]), __uint_as_float(rr[1])); }
DI f32x4 mfma16(bf16x8 a, bf16x8 b, f32x4 c) { return __builtin_amdgcn_mfma_f32_16x16x32_bf16(a, b, c, 0, 0, 0); }
DI bf16x8 pack8(float a0, float a1, float a2, float a3, float a4, float a5, float a6, float a7) {
  u32x4 w; w.x = pk2(a0, a1); w.y = pk2(a2, a3); w.z = pk2(a4, a5); w.w = pk2(a6, a7); return __builtin_bit_cast(bf16x8, w);
}
DI void unpack8(u32x4 w, float* v) {
  v[0] = lo2f(w.x); v[1] = hi2f(w.x); v[2] = lo2f(w.y); v[3] = hi2f(w.y); v[4] = lo2f(w.z); v[5] = hi2f(w.z); v[6] = lo2f(w.w); v[7] = hi2f(w.w);
}

#define XB_TMO      128
#define XB_XCNT(j)  (256  + 64 * (j))
#define XB_XSUB(j)  (1280 + 64 * (j))
#define XB_XGEN(j)  (2304 + 64 * (j))
#define XB_TOP      3328
#define XB_TOPGEN   3392
#define XCD_BAR_WORDS 3456
#define XB_SPIN_CAP (1u << 20)
#define LAS __attribute__((address_space(3)))
DI unsigned xb_ld(unsigned* p) { return __hip_atomic_load(p, __ATOMIC_RELAXED, __HIP_MEMORY_SCOPE_AGENT); }
DI unsigned xb_add(unsigned* p, unsigned v) { return __hip_atomic_fetch_add(p, v, __ATOMIC_RELAXED, __HIP_MEMORY_SCOPE_AGENT); }
DI unsigned xb_xcc_id() { return (unsigned)__builtin_amdgcn_s_getreg((3 << 11) | 20) & 0xFu; }
#define XB_SPIN(cond, bar) do { unsigned _sp = 0; while (cond) { __builtin_amdgcn_s_sleep(1); \
    if ((++_sp & 255u) == 0u) { if (xb_ld(&(bar)[XB_TMO])) break; if (_sp > XB_SPIN_CAP) { atomicAdd(&(bar)[XB_TMO], 1u); break; } } } } while (0)
struct XcdBarrier { unsigned* bar; unsigned x; volatile LAS unsigned* st; };
DI XcdBarrier xcd_barrier_post(unsigned* bar, volatile LAS unsigned* st) {
  XcdBarrier b; b.bar = bar; b.x = xb_xcc_id(); b.st = st;
  if (threadIdx.x == 0) (void)xb_add(&bar[XB_XCNT(b.x)], 1u);
  return b;
}
DI void xcd_barrier_complete(unsigned* bar, unsigned x, unsigned& nloc, unsigned& nx) {
  const unsigned G = gridDim.x * gridDim.y * gridDim.z;
  unsigned sum, cnt, mine, sp = 0u;
  for (;;) {
    sum = 0u; cnt = 0u; mine = 0u;
#pragma unroll
    for (unsigned j = 0; j < 16; ++j) { const unsigned c = xb_ld(&bar[XB_XCNT(j)]); sum += c; cnt += (c > 0u) ? 1u : 0u; mine = (j == x) ? c : mine; }
    if (sum == G) break;
    __builtin_amdgcn_s_sleep(1);
    if ((++sp & 255u) == 0u) { if (xb_ld(&bar[XB_TMO])) break; if (sp > XB_SPIN_CAP) { atomicAdd(&bar[XB_TMO], 1u); break; } }
  }
  nloc = mine > 0u ? mine : 1u; nx = cnt > 0u ? cnt : 1u;
}
DI void xcd_barrier(const XcdBarrier& b) {
  asm volatile("s_waitcnt vmcnt(0)" ::: "memory");
  __syncthreads();
  if (threadIdx.x == 0) {
    unsigned* bar = b.bar;
    __builtin_amdgcn_s_waitcnt(0);
    unsigned nloc = b.st[0], nx = b.st[1];
    if (nloc == 0u) { xcd_barrier_complete(bar, b.x, nloc, nx); b.st[0] = nloc; b.st[1] = nx; }
    const unsigned old = xb_add(&bar[XB_XSUB(b.x)], 1u);
    const unsigned gen = old / nloc;
    if (old + 1u == (gen + 1u) * nloc) {
      __builtin_amdgcn_fence(__ATOMIC_RELEASE, "agent");
      asm volatile("s_waitcnt vmcnt(0)" ::: "memory");
      const unsigned og = xb_add(&bar[XB_TOP], 1u);
      const unsigned tg = og / nx;
      if (og + 1u == (tg + 1u) * nx) xb_add(&bar[XB_TOPGEN], 1u);
      else XB_SPIN(xb_ld(&bar[XB_TOPGEN]) == tg, bar);
      __builtin_amdgcn_fence(__ATOMIC_ACQUIRE, "agent");
      xb_add(&bar[XB_XGEN(b.x)], 1u);
      asm volatile("s_waitcnt vmcnt(0)" ::: "memory");
    } else {
      XB_SPIN(xb_ld(&bar[XB_XGEN(b.x)]) == gen, bar);
      __builtin_amdgcn_fence(__ATOMIC_ACQUIRE, "agent");
      asm volatile("s_waitcnt vmcnt(0)" ::: "memory");
    }
  }
  __syncthreads();
}

template <bool SCALE>
DI void gemm_tile(const bf16_t* A, long lda, const bf16_t* Bt, long ldb, int K, unsigned char* smem, f32x4 (&acc)[4][4], int ksplit, const float (&rscale)[4]) {
  const int tid = otid(), lane = tid & 63, wave = tid >> 6, wr = wave >> 1, wc = wave & 1, r = lane & 15, quad = lane >> 4;
  bf16_t* sA = (bf16_t*)smem;
  bf16_t* sB = (bf16_t*)smem + 2 * 128 * 64;
#pragma unroll
  for (int i = 0; i < 4; ++i)
#pragma unroll
    for (int j = 0; j < 4; ++j) acc[i][j] = (f32x4){0.f, 0.f, 0.f, 0.f};
  const int lrow = tid >> 3, lcc = ((tid & 7) ^ (lrow & 7)) * 8;
  const bf16_t* ga = A + (long)lrow * lda + lcc;
  const bf16_t* gb = Bt + (long)lrow * ldb + lcc;
  const int x0 = (quad ^ (r & 7)) * 8, x1 = ((quad ^ (r & 7)) ^ 4) * 8;
  const int nk = K >> 6;
#define G_DMA(bo, kt) { _Pragma("unroll") for (int i = 0; i < 4; ++i) {                                                                                   \
      __builtin_amdgcn_global_load_lds((const unsigned*)(ga + (long)(32 * i) * lda + (kt) * 64), (unsigned*)(sA + (bo) + i * 2048 + tid * 8), 16, 0, 0);    \
      __builtin_amdgcn_global_load_lds((const unsigned*)(gb + (long)(32 * i) * ldb + (kt) * 64), (unsigned*)(sB + (bo) + i * 2048 + tid * 8), 16, 0, 0); } }
#define G_COMPUTE(bo, kt)                                                                                   \
  {                                                                                                         \
    const bf16_t* cA = sA + (bo) + (wr * 64 + r) * 64;                                                      \
    const bf16_t* cB = sB + (bo) + (wc * 64 + r) * 64;                                                      \
    _Pragma("unroll") for (int ks = 0; ks < 2; ++ks) {                                                      \
      const int xo = ks ? x1 : x0;                                                                          \
      bf16x8 af[4], bfr[4];                                                                                 \
      _Pragma("unroll") for (int i = 0; i < 4; ++i) { af[i] = *(const bf16x8*)(cA + i * 16 * 64 + xo); bfr[i] = *(const bf16x8*)(cB + i * 16 * 64 + xo); } \
      _Pragma("unroll") for (int i = 0; i < 4; ++i)                                                         \
        _Pragma("unroll") for (int j = 0; j < 4; ++j) acc[i][j] = mfma16(bfr[j], af[i], acc[i][j]);         \
    }                                                                                                       \
    if (SCALE) { if ((kt) + 1 == ksplit) {                                                                  \
      _Pragma("unroll") for (int i = 0; i < 4; ++i)                                                         \
        _Pragma("unroll") for (int j = 0; j < 4; ++j) acc[i][j] *= rscale[i]; } }                           \
  }
  __syncthreads();
  G_DMA(0, 0)
  __syncthreads();
#pragma unroll 1
  for (int kt = 0; kt < nk; ++kt) {
    const int cur = (kt & 1) * 8192, nxt = cur ^ 8192;
    const int kl = (kt + 1 < nk) ? kt + 1 : nk - 1;
    G_DMA(nxt, kl)
    G_COMPUTE(cur, kt)
    __syncthreads();
  }
#define G_LOAD
#undef G_LOAD
#undef G_DMA
#undef G_COMPUTE
}

template <int W>
DI void rows_rstd(const bf16_t* base, long ld, float eps, float* rs) {
  const int tid = otid(), row = tid >> 1, half = tid & 1;
  const bf16_t* ptr = base + (long)row * ld + half * (W >> 1);
  u32x4 v[W / 16];
#pragma unroll
  for (int i = 0; i < W / 16; ++i) v[i] = *(const u32x4*)(ptr + i * 8);
  float ss = 0.f;
#pragma unroll
  for (int i = 0; i < W / 16; ++i) {
    float f[8]; unpack8(v[i], f);
#pragma unroll
    for (int e = 0; e < 8; ++e) ss += f[e] * f[e];
  }
  ss += __shfl_xor(ss, 1);
  if (!half) rs[row] = rsqrtf(ss / (float)W + eps);
}

struct TrArgs { const float* src; const float* gain; bf16_t* dst; int N, ksrc0, n0, ldd, kdst0, remap; };
DI void transpose_tile2(const TrArgs& a0, const TrArgs& a1, unsigned char* smem) {
  const int tid = otid();
  f32x4 v4[2][4]; float gn[2][4];
#pragma unroll
  for (int u = 0; u < 2; ++u) {
    const TrArgs& a = u ? a1 : a0;
#pragma unroll
    for (int i = 0; i < 4; ++i) {
      const int idx4 = tid + 256 * i, kk = idx4 >> 4, n = a.n0 + (idx4 & 15) * 4;
      const int sn = a.remap ? win_src_col(n) : (n < a.N ? n : -1);
      v4[u][i] = (sn >= 0) ? __builtin_nontemporal_load((const f32x4*)(a.src + (long)(a.ksrc0 + kk) * a.N + sn)) : (f32x4){0.f, 0.f, 0.f, 0.f};
      gn[u][i] = a.gain ? a.gain[kk] : 1.f;
    }
  }
  __syncthreads();
#pragma unroll
  for (int u = 0; u < 2; ++u) {
    float* t = (float*)smem + u * (64 * 65);
#pragma unroll
    for (int i = 0; i < 4; ++i) {
      const int idx4 = tid + 256 * i, kk = idx4 >> 4, nn = (idx4 & 15) * 4;
      t[kk * 65 + nn] = v4[u][i][0] * gn[u][i]; t[kk * 65 + nn + 1] = v4[u][i][1] * gn[u][i]; t[kk * 65 + nn + 2] = v4[u][i][2] * gn[u][i]; t[kk * 65 + nn + 3] = v4[u][i][3] * gn[u][i];
    }
  }
  __syncthreads();
  const int nn = tid >> 2, kc = (tid & 3) * 16;
#pragma unroll
  for (int u = 0; u < 2; ++u) {
    const TrArgs& a = u ? a1 : a0;
    const float* t = (const float*)smem + u * (64 * 65);
    float v[16];
#pragma unroll
    for (int j = 0; j < 16; ++j) v[j] = t[(kc + j) * 65 + nn];
    u32x4 w0, w1;
    w0.x = pk2(v[0], v[1]); w0.y = pk2(v[2], v[3]); w0.z = pk2(v[4], v[5]); w0.w = pk2(v[6], v[7]);
    w1.x = pk2(v[8], v[9]); w1.y = pk2(v[10], v[11]); w1.z = pk2(v[12], v[13]); w1.w = pk2(v[14], v[15]);
    bf16_t* d = a.dst + (long)(a.n0 + nn) * a.ldd + a.kdst0 + kc;
    *(u32x4*)d = w0; *(u32x4*)(d + 8) = w1;
  }
}

constexpr int T_WIN = 32 * 82, T_WQ = 8 * 18, T_WKV = 4 * 24, T_WPW = 8 * 8, T_WOUT = 32 * 32;
constexpr int TR_PER_L = T_WIN + T_WQ + T_WKV + T_WPW + T_WOUT;
DI TrArgs tr_decode(const P& p, int it) {
  unsigned char* ws = p.ws;
  const int L = it / TR_PER_L; int r = it % TR_PER_L;
  TrArgs a; a.remap = 0;
  if (r < T_WIN) {
    a.remap = 1;
    const int kt = r % 32, nt = r / 32;
    a.src = p.w_in + (size_t)L * 2048 * NIN; a.N = NIN; a.ksrc0 = kt * 64; a.n0 = nt * 64; a.gain = p.norm_g + L * 2048 + kt * 64; a.dst = (bf16_t*)(ws + WS_WIN + L * SZ_WIN); a.ldd = LDX; a.kdst0 = kt * 64;
  } else if ((r -= T_WIN) < T_WQ) {
    const int kt = r % 8, nt = r / 8;
    a.src = p.w_q_b + (size_t)L * 512 * 1152; a.N = 1152; a.ksrc0 = kt * 64; a.n0 = nt * 64; a.gain = p.q_a_norm + L * 512 + kt * 64; a.dst = (bf16_t*)(ws + WS_WQ + L * SZ_WQ); a.ldd = LDQW; a.kdst0 = kt * 64;
  } else if ((r -= T_WQ) < T_WKV) {
    const int kt = r % 4, nt = r / 4;
    a.src = p.w_kv_b + (size_t)L * 256 * 1536; a.N = 1536; a.ksrc0 = kt * 64; a.n0 = nt * 64; a.gain = p.kv_a_norm + L * 256 + kt * 64; a.dst = (bf16_t*)(ws + WS_WKV + L * SZ_WKV); a.ldd = LDKVW; a.kdst0 = kt * 64;
  } else if ((r -= T_WKV) < T_WPW) {
    const int kt = r % 8, nt = r / 8;
    a.src = p.conv_pw_w + (size_t)L * 512 * 512; a.N = 512; a.ksrc0 = kt * 64; a.n0 = nt * 64; a.gain = nullptr; a.dst = (bf16_t*)(ws + WS_WPW + L * SZ_WPW); a.ldd = LDPW; a.kdst0 = kt * 64;
  } else {
    r -= T_WPW;
    const int kt = r % 32, nt = r / 32, kd = kt * 64;
    a.src = p.w_out + (size_t)L * 2048 * 2048; a.N = 2048; a.ksrc0 = (kd < 768) ? kd + 1280 : kd - 768; a.n0 = nt * 64; a.gain = (kd < 768) ? p.ssd_norm_g + L * 768 + kd : nullptr;
    a.dst = (bf16_t*)(ws + WS_WOUT + L * SZ_WOUT); a.ldd = LDX; a.kdst0 = kd;
  }
  return a;
}

DI void phase0(const P& p, unsigned char* smem) {
  const int tid = otid();
  unsigned char* ws = p.ws;
  constexpr int N_TR = 2 * TR_PER_L, N_TR2 = N_TR / 2, N_X = T / 4, N_ROPE = 4096 * 32 / 256;
  static_assert(N_TR % 2 == 0, "pairs");
  for (int it = blockIdx.x; it < N_TR2 + N_X + N_ROPE; it += gridDim.x) {
    if (it < N_TR2) {
      const TrArgs a0 = tr_decode(p, 2 * it), a1 = tr_decode(p, 2 * it + 1);
      transpose_tile2(a0, a1, smem);
    } else if (it < N_TR2 + N_X) {
      const int row = (it - N_TR2) * 4 + (tid >> 6), lane = tid & 63;
      const float* xr = p.x + (size_t)row * 2048;
      bf16_t* xb = (bf16_t*)(ws + WS_XBA) + (size_t)row * LDX;
      float ss = 0.f;
#pragma unroll
      for (int i = 0; i < 8; ++i) {
        f32x4 v = __builtin_nontemporal_load((const f32x4*)(xr + lane * 4 + 256 * i));
        ss += v[0] * v[0] + v[1] * v[1] + v[2] * v[2] + v[3] * v[3];
        u32x2 w; w.x = pk2(v[0], v[1]); w.y = pk2(v[2], v[3]);
        *(u32x2*)(xb + lane * 4 + 256 * i) = w;
      }
#pragma unroll
      for (int o = 1; o < 64; o <<= 1) ss += __shfl_xor(ss, o);
      if (lane == 0) ((float*)(ws + WS_SSX))[row] = ss;
    } else {
      const int idx = (it - N_TR2 - N_X) * 256 + tid, s = idx >> 5, i = idx & 31;
      const float invf = (float)exp(-(double)i * (9.210340371976184 / 32.0));
      const float ang = (float)s * invf;
      double rev = (double)ang * 0.15915494309189535; rev -= floor(rev);
      ((float*)(ws + WS_COS))[idx] = __builtin_amdgcn_cosf((float)rev);
      ((float*)(ws + WS_SIN))[idx] = __builtin_amdgcn_sinf((float)rev);
    }
  }
}
DI void inproj_tile(const P& p, int L, int mt_, int nt_, unsigned char* smem) {
  unsigned char* ws = p.ws;
  const bf16_t* xb = (const bf16_t*)(ws + (L == 0 ? WS_XBA : WS_XBB));
  const bf16_t* W = (const bf16_t*)(ws + WS_WIN + L * SZ_WIN);
  bf16_t* U = (bf16_t*)(ws + WS_U);
  float* dtraw = (float*)(ws + WS_DTRAW);
  const float* ssx = (const float*)(ws + WS_SSX);
  const int tid = otid(), lane = tid & 63, wave = tid >> 6, wr = wave >> 1, wc = wave & 1, r = lane & 15, quad = lane >> 4;
  f32x4 acc[4][4]; const float dummy[4] = {1.f, 1.f, 1.f, 1.f};
  gemm_tile<false>(xb + (size_t)mt_ * 128 * LDX, LDX, W + (size_t)nt_ * 128 * LDX, LDX, 2048, smem, acc, 0, dummy);
#pragma unroll
  for (int i = 0; i < 4; ++i) {
    const int row = mt_ * 128 + wr * 64 + i * 16 + r;
    const float rs = rsqrtf(ssx[row] * (1.f / 2048.f) + 1e-6f);
#pragma unroll
    for (int j = 0; j < 4; ++j) {
      const int col = nt_ * 128 + wc * 64 + j * 16 + quad * 4;
      f32x4 v = acc[i][j] * rs;
      if (col >= U_DT && col < U_DT + 12) { *(f32x4*)(dtraw + (size_t)row * 12 + (col - U_DT)) = v; }
      else { u32x2 w; w.x = pk2(v[0], v[1]); w.y = pk2(v[2], v[3]); *(u32x2*)(U + (size_t)row * LDU + col) = w; }
    }
  }
}
DI void phase1(const P& p, int L, unsigned char* smem) {
  constexpr int NTILE = 64 * 40;
  for (int t = blockIdx.x; t < NTILE; t += gridDim.x) {
    const int mg = t / (16 * 40), rr = t % (16 * 40), mt_ = mg * 16 + rr / 40, nt_ = rr % 40;
    inproj_tile(p, L, mt_, nt_, smem);
  }
}

DI void kv_item(const P& p, int L, int mt_, int j, unsigned char* smem) {
  unsigned char* ws = p.ws;
  const bf16_t* U = (const bf16_t*)(ws + WS_U);
  const bf16_t* W = (const bf16_t*)(ws + WS_WKV + L * SZ_WKV);
  const int tid = otid(), lane = tid & 63, wave = tid >> 6, wr = wave >> 1, wc = wave & 1, r = lane & 15, quad = lane >> 4;
  const int tok0 = mt_ * 128, h = j >> 1, part = j & 1, b = tok0 >> 12, s0 = tok0 & 4095;
  float* rs_s = (float*)(smem + GEMM_SM);
  float* red = rs_s + 128;
  float* pe_ss = red + 256;
  float* rk_s = pe_ss + 128;
  const bf16_t* ckv = U + (size_t)tok0 * LDU + U_CKV;
  __syncthreads();
  rows_rstd<256>(ckv, LDU, 1e-6f, rs_s);
  f32x4 acc[4][4]; const float dummy[4] = {1.f, 1.f, 1.f, 1.f};
  if (part == 0) {
    gemm_tile<false>(ckv, LDU, W + (size_t)(h * 256) * LDKVW, LDKVW, 256, smem, acc, 0, dummy);
#pragma unroll
    for (int i = 0; i < 4; ++i) {
      const int row = wr * 64 + i * 16 + r; const float rsv = rs_s[row]; float s = 0.f;
#pragma unroll
      for (int jj = 0; jj < 4; ++jj) { acc[i][jj] *= rsv; s += acc[i][jj][0] * acc[i][jj][0] + acc[i][jj][1] * acc[i][jj][1] + acc[i][jj][2] * acc[i][jj][2] + acc[i][jj][3] * acc[i][jj][3]; }
      s += __shfl_xor(s, 16); s += __shfl_xor(s, 32);
      if (quad == 0) red[row * 2 + wc] = s;
    }
    {
      const int row = tid >> 1, half = tid & 1; const bf16_t* ptr = U + (size_t)(tok0 + row) * LDU + U_KPE + half * 32; float ss = 0.f;
#pragma unroll
      for (int i = 0; i < 4; ++i) { u32x4 v = *(const u32x4*)(ptr + i * 8); float f[8]; unpack8(v, f);
#pragma unroll
        for (int e = 0; e < 8; ++e) ss += f[e] * f[e]; }
      ss += __shfl_xor(ss, 1);
      if (!half) pe_ss[row] = ss;
    }
    __syncthreads();
    bf16_t* Kn = (bf16_t*)(ws + WS_KN) + ((size_t)(b * 6 + h) * 4096 + s0) * 192;
    const float* kn = p.k_norm + L * 192;
#pragma unroll
    for (int i = 0; i < 4; ++i) {
      const int row = wr * 64 + i * 16 + r;
      const float rk = rsqrtf((red[row * 2] + red[row * 2 + 1] + pe_ss[row]) * (1.f / 192.f) + 1e-6f);
      if (wc == 0 && quad == 0) rk_s[row] = rk;
#pragma unroll
      for (int jj = 0; jj < 4; ++jj) {
        const int col = wc * 64 + jj * 16 + quad * 4;
        const f32x4 g = *(const f32x4*)(kn + col);
        f32x4 v = acc[i][jj] * rk * g;
        u32x2 w; w.x = pk2(v[0], v[1]); w.y = pk2(v[2], v[3]);
        *(u32x2*)(Kn + (size_t)row * 192 + col) = w;
      }
    }
    __syncthreads();
    const float* cosT = (const float*)(ws + WS_COS); const float* sinT = (const float*)(ws + WS_SIN);
#pragma unroll 4
    for (int i = 0; i < 16; ++i) {
      const int idx = tid + 256 * i, row = idx >> 5, ii = idx & 31;
      const bf16_t* pe = U + (size_t)(tok0 + row) * LDU + U_KPE;
      const float rk = rk_s[row];
      const float x1 = bf2f(pe[ii]) * rk * kn[128 + ii], x2 = bf2f(pe[32 + ii]) * rk * kn[160 + ii];
      const float c = cosT[(s0 + row) * 32 + ii], sn = sinT[(s0 + row) * 32 + ii];
      Kn[(size_t)row * 192 + 128 + ii] = f2bf(x1 * c - x2 * sn);
      Kn[(size_t)row * 192 + 160 + ii] = f2bf(x2 * c + x1 * sn);
    }
  } else {
    gemm_tile<false>(W + (size_t)(h * 256 + 128) * LDKVW, LDKVW, ckv, LDU, 256, smem, acc, 0, dummy);
    bf16_t* Vt = (bf16_t*)(ws + WS_VT) + ((size_t)(b * 6 + h) * 128) * LDVT + s0;
#pragma unroll
    for (int i = 0; i < 4; ++i) {
      const int d = wr * 64 + i * 16 + r;
#pragma unroll
      for (int jj = 0; jj < 4; ++jj) {
        const int col = wc * 64 + jj * 16 + quad * 4;
        const f32x4 rv = *(const f32x4*)(rs_s + col);
        f32x4 v = acc[i][jj] * rv;
        u32x2 w; w.x = pk2(v[0], v[1]); w.y = pk2(v[2], v[3]);
        *(u32x2*)(Vt + (size_t)d * LDVT + col) = w;
      }
    }
  }
}
DI void q_item(const P& p, int L, int mt_, int nt_, unsigned char* smem) {
  unsigned char* ws = p.ws;
  const bf16_t* U = (const bf16_t*)(ws + WS_U);
  const bf16_t* W = (const bf16_t*)(ws + WS_WQ + L * SZ_WQ);
  bf16_t* Q = (bf16_t*)(ws + WS_QRAW);
  const int tid = otid(), lane = tid & 63, wave = tid >> 6, wr = wave >> 1, wc = wave & 1, r = lane & 15, quad = lane >> 4;
  const int tok0 = mt_ * 128;
  float* rs_s = (float*)(smem + GEMM_SM);
  __syncthreads();
  rows_rstd<512>(U + (size_t)tok0 * LDU + U_CQ, LDU, 1e-6f, rs_s);
  f32x4 acc[4][4]; const float dummy[4] = {1.f, 1.f, 1.f, 1.f};
  gemm_tile<false>(U + (size_t)tok0 * LDU + U_CQ, LDU, W + (size_t)nt_ * 128 * LDQW, LDQW, 512, smem, acc, 0, dummy);
#pragma unroll
  for (int i = 0; i < 4; ++i) {
    const int row = wr * 64 + i * 16 + r; const float rs = rs_s[row];
#pragma unroll
    for (int jj = 0; jj < 4; ++jj) {
      const int col = nt_ * 128 + wc * 64 + jj * 16 + quad * 4;
      f32x4 v = acc[i][jj] * rs;
      u32x2 w; w.x = pk2(v[0], v[1]); w.y = pk2(v[2], v[3]);
      *(u32x2*)(Q + (size_t)(tok0 + row) * 1152 + col) = w;
    }
  }
}
DI void conv_item(const P& p, int L, int it, unsigned char* smem) {
  unsigned char* ws = p.ws;
  const bf16_t* U = (const bf16_t*)(ws + WS_U);
  bf16_t* HC = (bf16_t*)(ws + (L == 0 ? WS_HC : WS_WIN));
  const int tid = otid(), lane = tid & 63, wave = tid >> 6;
  const int tok0 = it * 16, b = tok0 >> 12, s0 = tok0 & 4095;
  bf16_t* glu = (bf16_t*)smem;
  float* part = (float*)(smem + 46 * 512 * 2);
  __syncthreads();
#pragma unroll
  for (int pass = 0; pass < 2; ++pass) {
    u32x4 av[6], gv[6];
#pragma unroll
    for (int k = 0; k < 6; ++k) {
      const int c = tid + 256 * (pass * 6 + k), ri = c >> 6, cc = c & 63, sq = s0 - 30 + ri;
      av[k] = (u32x4){0u, 0u, 0u, 0u}; gv[k] = (u32x4){0u, 0u, 0u, 0u};
      if (c < 46 * 64 && sq >= 0) {
        const bf16_t* up = U + (size_t)(b * 4096 + sq) * LDU;
        av[k] = *(const u32x4*)(up + U_CA + cc * 8); gv[k] = *(const u32x4*)(up + U_CG + cc * 8);
      }
    }
#pragma unroll
    for (int k = 0; k < 6; ++k) {
      const int c = tid + 256 * (pass * 6 + k), ri = c >> 6, cc = c & 63;
      if (c < 46 * 64) {
        float fa[8], fg[8]; unpack8(av[k], fa); unpack8(gv[k], fg);
        u32x4 o;
        o.x = pk2(fa[0] * sigmoidf_(fg[0]), fa[1] * sigmoidf_(fg[1])); o.y = pk2(fa[2] * sigmoidf_(fg[2]), fa[3] * sigmoidf_(fg[3]));
        o.z = pk2(fa[4] * sigmoidf_(fg[4]), fa[5] * sigmoidf_(fg[5])); o.w = pk2(fa[6] * sigmoidf_(fg[6]), fa[7] * sigmoidf_(fg[7]));
        *(u32x4*)(glu + ri * 512 + cc * 8) = o;
      }
    }
  }
  __syncthreads();
  const int ch = tid * 2;
  const float* wdw = p.conv_dw_w + (size_t)L * 31 * 512 + ch;
  float w0[31], w1[31];
#pragma unroll
  for (int j = 0; j < 31; ++j) { w0[j] = wdw[j * 512]; w1[j] = wdw[j * 512 + 1]; }
  const float b0 = p.conv_dw_b[L * 512 + ch], b1 = p.conv_dw_b[L * 512 + ch + 1];
  float o0[16], o1[16];
#pragma unroll
  for (int tb = 0; tb < 4; ++tb) {
    unsigned v[34];
#pragma unroll
    for (int i = 0; i < 34; ++i) v[i] = *(const unsigned*)(glu + (tb * 4 + i) * 512 + ch);
#pragma unroll
    for (int tt = 0; tt < 4; ++tt) {
      float a0 = b0, a1 = b1;
#pragma unroll
      for (int j = 0; j < 31; ++j) { a0 += w0[j] * lo2f(v[tt + j]); a1 += w1[j] * hi2f(v[tt + j]); }
      o0[tb * 4 + tt] = a0; o1[tb * 4 + tt] = a1;
      float s1 = a0 + a1, s2 = a0 * a0 + a1 * a1;
#pragma unroll
      for (int o = 1; o < 64; o <<= 1) { s1 += __shfl_xor(s1, o); s2 += __shfl_xor(s2, o); }
      if (lane == 0) { part[((tb * 4 + tt) * 4 + wave) * 2] = s1; part[((tb * 4 + tt) * 4 + wave) * 2 + 1] = s2; }
    }
  }
  __syncthreads();
  const float g0 = p.conv_ln_g[L * 512 + ch], g1 = p.conv_ln_g[L * 512 + ch + 1], lb0 = p.conv_ln_b[L * 512 + ch], lb1 = p.conv_ln_b[L * 512 + ch + 1];
#pragma unroll
  for (int tk = 0; tk < 16; ++tk) {
    const float S1 = part[(tk * 4 + 0) * 2] + part[(tk * 4 + 1) * 2] + part[(tk * 4 + 2) * 2] + part[(tk * 4 + 3) * 2];
    const float S2 = part[(tk * 4 + 0) * 2 + 1] + part[(tk * 4 + 1) * 2 + 1] + part[(tk * 4 + 2) * 2 + 1] + part[(tk * 4 + 3) * 2 + 1];
    const float mean = S1 * (1.f / 512.f); float var = S2 * (1.f / 512.f) - mean * mean; var = var < 0.f ? 0.f : var;
    const float rstd = rsqrtf(var + 1e-5f);
    const float y0 = (o0[tk] - mean) * rstd * g0 + lb0, y1 = (o1[tk] - mean) * rstd * g1 + lb1;
    *(unsigned*)(HC + (size_t)(tok0 + tk) * LDHC + ch) = pk2(siluf_(y0), siluf_(y1));
  }
}
DI void ssdconv_item(const P& p, int L, int it) {
  unsigned char* ws = p.ws;
  const bf16_t* U = (const bf16_t*)(ws + WS_U);
  bf16_t* XC = (bf16_t*)(ws + WS_XBCC);
  const int tid = otid();
  const int tok0 = it * 16, b = tok0 >> 12, s0 = tok0 & 4095;
  const float* cw = p.ssd_conv_w + (size_t)L * 4 * 1280; const float* cb = p.ssd_conv_b + L * 1280;
#pragma unroll 1
  for (int c0 = tid; c0 < 16 * 160; c0 += 512) {
    u32x4 v[2][4];
#pragma unroll
    for (int u = 0; u < 2; ++u) {
      const int c = c0 + 256 * u, tk = c / 160, cc = c % 160, sq = s0 + tk;
#pragma unroll
      for (int j = 0; j < 4; ++j) {
        const int sp = sq - 3 + j;
        v[u][j] = (u32x4){0u, 0u, 0u, 0u};
        if (sp >= 0) v[u][j] = *(const u32x4*)(U + (size_t)(b * 4096 + sp) * LDU + U_XBC + cc * 8);
      }
    }
#pragma unroll
    for (int u = 0; u < 2; ++u) {
      const int c = c0 + 256 * u, tk = c / 160, cc = c % 160;
      float a[8];
      { f32x4 b0 = *(const f32x4*)(cb + cc * 8), b1 = *(const f32x4*)(cb + cc * 8 + 4); a[0] = b0[0]; a[1] = b0[1]; a[2] = b0[2]; a[3] = b0[3]; a[4] = b1[0]; a[5] = b1[1]; a[6] = b1[2]; a[7] = b1[3]; }
#pragma unroll
      for (int j = 0; j < 4; ++j) {
        float f[8]; unpack8(v[u][j], f);
        f32x4 w0 = *(const f32x4*)(cw + j * 1280 + cc * 8), w1 = *(const f32x4*)(cw + j * 1280 + cc * 8 + 4);
        a[0] += f[0] * w0[0]; a[1] += f[1] * w0[1]; a[2] += f[2] * w0[2]; a[3] += f[3] * w0[3];
        a[4] += f[4] * w1[0]; a[5] += f[5] * w1[1]; a[6] += f[6] * w1[2]; a[7] += f[7] * w1[3];
      }
      u32x4 o; o.x = pk2(siluf_(a[0]), siluf_(a[1])); o.y = pk2(siluf_(a[2]), siluf_(a[3])); o.z = pk2(siluf_(a[4]), siluf_(a[5])); o.w = pk2(siluf_(a[6]), siluf_(a[7]));
      *(u32x4*)(XC + (size_t)(tok0 + tk) * 1280 + cc * 8) = o;
    }
  }
}

DI void dt_item(const P& p, int L, int it, unsigned char* smem) {
  unsigned char* ws = p.ws;
  const float* dtraw = (const float*)(ws + WS_DTRAW);
  float* dtg = (float*)(ws + WS_DT); float* acs = (float*)(ws + WS_ACS);
  const int tid = otid(), tok0 = it * 128;
  float* a_s = (float*)smem;
  __syncthreads();
  for (int idx = tid; idx < 1536; idx += 256) {
    const int l = idx / 12, h = idx % 12;
    const float raw = dtraw[(size_t)(tok0 + l) * 12 + h] + p.ssd_dt_bias[L * 12 + h];
    const float dtv = fmaxf(raw, 0.f) + log1pf(expf(-fabsf(raw)));
    dtg[(size_t)(tok0 + l) * 12 + h] = dtv;
    a_s[h * 128 + l] = dtv * (-expf(p.ssd_A_log[L * 12 + h]));
  }
  __syncthreads();
  for (int idx = tid; idx < 1536; idx += 256) {
    const int l = idx & 127, h = idx >> 7;
    float cs = 0.f;
    for (int i = 0; i <= l; ++i) cs += a_s[h * 128 + i];
    acs[(size_t)(tok0 + l) * 12 + h] = cs;
  }
  if (tid < 128) ((float*)(ws + WS_SSS))[tok0 + tid] = 0.f;
}
DI void attn_item(const P& p, int L, int b, int h, int qb, int t_lo, int t_hi, int part, unsigned char* smem) {
  unsigned char* ws = p.ws;
  const bf16_t* U = (const bf16_t*)(ws + WS_U);
  const bf16_t* Qr = (const bf16_t*)(ws + WS_QRAW);
  const bf16_t* Kg = (const bf16_t*)(ws + WS_KN) + (size_t)(b * 6 + h) * 4096 * 192;
  const bf16_t* Vg = (const bf16_t*)(ws + WS_VT) + (size_t)(b * 6 + h) * 128 * LDVT;
  bf16_t* MIX = (bf16_t*)(ws + WS_XBA);
  const float* cosT = (const float*)(ws + WS_COS); const float* sinT = (const float*)(ws + WS_SIN);
  const int tid = otid(), lane = tid & 63, w = tid >> 6, r = lane & 15, quad = lane >> 4;
  bf16_t* Ks = (bf16_t*)smem;
  bf16_t* Vs = (bf16_t*)(smem + 2 * 64 * 192 * 2);
  const int qrow0 = qb * 128 + 32 * w;
  const float QSCALE = 0.07216878364870322f * 1.4426950408889634f;
  {
    bf16_t* Qs = (bf16_t*)smem;
    const int prow = tid >> 1, half = tid & 1, pos = qb * 128 + prow;
    const bf16_t* qp = Qr + (size_t)(b * 4096 + pos) * 1152 + h * 192 + half * 96;
    float ss = 0.f;
#pragma unroll
    for (int c = 0; c < 12; ++c) { const u32x4 raw = *(const u32x4*)(qp + c * 8); float f[8]; unpack8(raw, f);
#pragma unroll
      for (int e = 0; e < 8; ++e) ss += f[e] * f[e]; }
    ss += __shfl_xor(ss, 1);
    const float rq = rsqrtf(ss * (1.f / 192.f) + 1e-6f) * QSCALE;
    const float* qn = p.q_norm + L * 192 + half * 96;
    bf16_t* qs = Qs + prow * 200 + half * 96;
    const int nplain = half ? 4 : 12;
#pragma unroll 1
    for (int c = 0; c < nplain; ++c) {
      const u32x4 raw = *(const u32x4*)(qp + c * 8); float f[8]; unpack8(raw, f);
      const f32x4 g0 = *(const f32x4*)(qn + c * 8), g1 = *(const f32x4*)(qn + c * 8 + 4);
      u32x4 wv; wv.x = pk2(f[0] * rq * g0[0], f[1] * rq * g0[1]); wv.y = pk2(f[2] * rq * g0[2], f[3] * rq * g0[3]);
      wv.z = pk2(f[4] * rq * g1[0], f[5] * rq * g1[1]); wv.w = pk2(f[6] * rq * g1[2], f[7] * rq * g1[3]);
      *(u32x4*)(qs + c * 8) = wv;
    }
    if (half) {
#pragma unroll 1
      for (int c = 4; c < 8; ++c) {
        const u32x4 rawa = *(const u32x4*)(qp + c * 8), rawb = *(const u32x4*)(qp + (c + 4) * 8);
        float fa[8], fb[8]; unpack8(rawa, fa); unpack8(rawb, fb);
        float ra[8], rb[8];
#pragma unroll
        for (int e = 0; e < 8; ++e) {
          const float xa = fa[e] * rq * qn[c * 8 + e], xb = fb[e] * rq * qn[(c + 4) * 8 + e];
          const float cc = cosT[pos * 32 + (c - 4) * 8 + e], sn = sinT[pos * 32 + (c - 4) * 8 + e];
          ra[e] = xa * cc - xb * sn; rb[e] = xb * cc + xa * sn;
        }
        u32x4 wa, wb;
        wa.x = pk2(ra[0], ra[1]); wa.y = pk2(ra[2], ra[3]); wa.z = pk2(ra[4], ra[5]); wa.w = pk2(ra[6], ra[7]);
        wb.x = pk2(rb[0], rb[1]); wb.y = pk2(rb[2], rb[3]); wb.z = pk2(rb[4], rb[5]); wb.w = pk2(rb[6], rb[7]);
        *(u32x4*)(qs + c * 8) = wa; *(u32x4*)(qs + (c + 4) * 8) = wb;
      }
    }
  }
  __syncthreads();
  bf16x8 qf[2][6];
#pragma unroll
  for (int qt = 0; qt < 2; ++qt)
#pragma unroll
    for (int ks = 0; ks < 6; ++ks) qf[qt][ks] = *(const bf16x8*)((const bf16_t*)smem + (32 * w + 16 * qt + r) * 200 + ks * 32 + quad * 8);
  int kgo[6];
#pragma unroll
  for (int i = 0; i < 6; ++i) { const int c = i * 256 + tid, row = c / 24, pc = c % 24; kgo[i] = row * 192 + ((pc & 24) | ((pc & 7) ^ (row & 7))) * 8; }
  const int vkey = ((tid >> 3) & 7) ^ ((tid >> 6) & 1);
  const size_t vgo = (size_t)(tid >> 3) * LDVT + ((tid & 7) ^ vkey) * 8;
#define ATT_DMAK(buf, jt) { _Pragma("unroll") for (int i = 0; i < 6; ++i)                                                                   \
    __builtin_amdgcn_global_load_lds((const unsigned*)(Kg + (size_t)(jt) * 64 * 192 + kgo[i]), (unsigned*)(Ks + (buf) * 64 * 192 + (i * 256 + tid) * 8), 16, 0, 0); }
#define ATT_DMAV(jt) { _Pragma("unroll") for (int i = 0; i < 4; ++i)                                                                        \
    __builtin_amdgcn_global_load_lds((const unsigned*)(Vg + vgo + (size_t)i * 32 * LDVT + (jt) * 64), (unsigned*)(Vs + (i * 256 + tid) * 8), 16, 0, 0); }
  __syncthreads();
  ATT_DMAK(0, t_lo)
  float m[2] = {-INFINITY, -INFINITY}, l[2] = {0.f, 0.f};
  f32x4 o[8][2];
#pragma unroll
  for (int dt = 0; dt < 8; ++dt) { o[dt][0] = (f32x4){0.f, 0.f, 0.f, 0.f}; o[dt][1] = (f32x4){0.f, 0.f, 0.f, 0.f}; }
  for (int jt = t_lo; jt < t_hi; ++jt) {
    const int kcur = ((jt - t_lo) & 1) * 64 * 192;
    __syncthreads();
    ATT_DMAV(jt)
    { const int jn = (jt + 1 < t_hi) ? jt + 1 : jt; ATT_DMAK((((jt - t_lo) & 1) ^ 1), jn) }
    const int kstart = jt * 64;
    const bool active = (kstart <= qrow0 + 31);
    f32x4 s[4][2];
    if (active) {
#pragma unroll
      for (int kt = 0; kt < 4; ++kt) { s[kt][0] = (f32x4){0.f, 0.f, 0.f, 0.f}; s[kt][1] = (f32x4){0.f, 0.f, 0.f, 0.f}; }
      {
        const bf16_t* kbase = Ks + kcur + r * 192;
        const int kx0 = (quad ^ (r & 7)) * 8, kx1 = kx0 ^ 32;
        bf16x8 kf[2][4];
#pragma unroll
        for (int kt = 0; kt < 4; ++kt) kf[0][kt] = *(const bf16x8*)(kbase + kt * 16 * 192 + kx0);
#pragma unroll
        for (int ks = 0; ks < 6; ++ks) {
          if (ks < 5) {
#pragma unroll
            for (int kt = 0; kt < 4; ++kt) kf[(ks + 1) & 1][kt] = *(const bf16x8*)(kbase + kt * 16 * 192 + ((ks + 1) >> 1) * 64 + (((ks + 1) & 1) ? kx1 : kx0));
          }
#pragma unroll
          for (int kt = 0; kt < 4; ++kt) {
            s[kt][0] = mfma16(kf[ks & 1][kt], qf[0][ks], s[kt][0]);
            s[kt][1] = mfma16(kf[ks & 1][kt], qf[1][ks], s[kt][1]);
          }
          __builtin_amdgcn_sched_barrier(0);
        }
      }
      const bool need_mask = (kstart + 63 > qrow0);
#pragma unroll
      for (int qt = 0; qt < 2; ++qt) {
        const int qpos = qrow0 + 16 * qt + r;
        if (need_mask) {
#pragma unroll
          for (int kt = 0; kt < 4; ++kt)
#pragma unroll
            for (int t = 0; t < 4; ++t) if (kstart + kt * 16 + quad * 4 + t > qpos) s[kt][qt][t] = -INFINITY;
        }
        float mx = -INFINITY;
#pragma unroll
        for (int kt = 0; kt < 4; ++kt) mx = fmaxf(mx, fmaxf(fmaxf(s[kt][qt][0], s[kt][qt][1]), fmaxf(s[kt][qt][2], s[kt][qt][3])));
        mx = xmax32(xmax16(mx));
        if (!__all(mx - m[qt] <= 8.f)) {
          const float mnew = fmaxf(m[qt], mx);
          const float alpha = __builtin_amdgcn_exp2f(m[qt] - mnew);
          m[qt] = mnew; l[qt] *= alpha;
#pragma unroll
          for (int dt = 0; dt < 8; ++dt) o[dt][qt] *= alpha;
        }
        const float mref = m[qt];
        float rsum = 0.f;
#pragma unroll
        for (int kt = 0; kt < 4; ++kt)
#pragma unroll
          for (int t = 0; t < 4; ++t) { const float pv = __builtin_amdgcn_exp2f(s[kt][qt][t] - mref); s[kt][qt][t] = pv; rsum += pv; }
        l[qt] += rsum;
      }
    }
    __syncthreads();
    if (active) {
      const int vkr = (r & 7) ^ ((r >> 3) & 1), vx8 = ((quad >> 1) ^ vkr) * 8, vq = (quad & 1) * 4;
#pragma unroll
      for (int k2 = 0; k2 < 2; ++k2) {
        const bf16x8 pf0 = pack8(s[2 * k2][0][0], s[2 * k2][0][1], s[2 * k2][0][2], s[2 * k2][0][3], s[2 * k2 + 1][0][0], s[2 * k2 + 1][0][1], s[2 * k2 + 1][0][2], s[2 * k2 + 1][0][3]);
        const bf16x8 pf1 = pack8(s[2 * k2][1][0], s[2 * k2][1][1], s[2 * k2][1][2], s[2 * k2][1][3], s[2 * k2 + 1][1][0], s[2 * k2 + 1][1][1], s[2 * k2 + 1][1][2], s[2 * k2 + 1][1][3]);
        const bf16_t* vb0 = Vs + r * 64 + (vx8 ^ (k2 * 32)) + vq;
        const bf16_t* vb1 = Vs + r * 64 + (vx8 ^ (k2 * 32 + 16)) + vq;
        bf16x4 va[2][2], vb[2][2];
#pragma unroll
        for (int u = 0; u < 2; ++u) { va[0][u] = *(const bf16x4*)(vb0 + u * 16 * 64); vb[0][u] = *(const bf16x4*)(vb1 + u * 16 * 64); }
#pragma unroll
        for (int d2 = 0; d2 < 4; ++d2) {
          if (d2 < 3) {
#pragma unroll
            for (int u = 0; u < 2; ++u) { va[(d2 + 1) & 1][u] = *(const bf16x4*)(vb0 + ((d2 + 1) * 2 + u) * 16 * 64); vb[(d2 + 1) & 1][u] = *(const bf16x4*)(vb1 + ((d2 + 1) * 2 + u) * 16 * 64); }
          }
#pragma unroll
          for (int u = 0; u < 2; ++u) {
            const bf16x8 vf = __builtin_shufflevector(va[d2 & 1][u], vb[d2 & 1][u], 0, 1, 2, 3, 4, 5, 6, 7);
            o[d2 * 2 + u][0] = mfma16(vf, pf0, o[d2 * 2 + u][0]);
            o[d2 * 2 + u][1] = mfma16(vf, pf1, o[d2 * 2 + u][1]);
          }
        }
      }
    }
  }
#undef ATT_DMAK
#undef ATT_DMAV
#pragma unroll
  for (int qt = 0; qt < 2; ++qt) {
    float lt = l[qt]; lt += __shfl_xor(lt, 16); lt += __shfl_xor(lt, 32);
    const float inv = 1.f / lt;
    if (part < 0) {
      const size_t tok = (size_t)b * 4096 + qrow0 + 16 * qt + r;
#pragma unroll
      for (int dt = 0; dt < 8; ++dt) {
        const int col = h * 128 + dt * 16 + quad * 4;
        const u32x2 g = *(const u32x2*)(U + tok * LDU + U_GMLA + col);
        f32x4 v = o[dt][qt] * inv;
        u32x2 wv; wv.x = pk2(v[0] * siluf_(lo2f(g.x)), v[1] * siluf_(hi2f(g.x))); wv.y = pk2(v[2] * siluf_(lo2f(g.y)), v[3] * siluf_(hi2f(g.y)));
        *(u32x2*)(MIX + tok * LDX + MIX_MLA + col) = wv;
      }
    } else {
      const size_t slot = ((size_t)(b * 6 + h) * 16 + (qb - 16)) * 2 + part;
      const int row = 32 * w + 16 * qt + r;
      bf16_t* po = (bf16_t*)(ws + WS_PO) + (slot * 128 + row) * 128;
#pragma unroll
      for (int dt = 0; dt < 8; ++dt) {
        f32x4 v = o[dt][qt] * inv;
        u32x2 wv; wv.x = pk2(v[0], v[1]); wv.y = pk2(v[2], v[3]);
        *(u32x2*)(po + dt * 16 + quad * 4) = wv;
      }
      if (quad == 0) { float* pml = (float*)(ws + WS_PML) + (slot * 128 + row) * 2; pml[0] = m[qt]; pml[1] = lt; }
    }
  }
}

DI void pw_item(const P& p, int L, int mt_, int nt_, unsigned char* smem) {
  unsigned char* ws = p.ws;
  const bf16_t* U = (const bf16_t*)(ws + WS_U);
  const bf16_t* HC = (const bf16_t*)(ws + (L == 0 ? WS_HC : WS_WIN));
  const bf16_t* W = (const bf16_t*)(ws + WS_WPW + L * SZ_WPW);
  bf16_t* MIX = (bf16_t*)(ws + WS_XBA);
  const int tid = otid(), lane = tid & 63, wave = tid >> 6, wr = wave >> 1, wc = wave & 1, r = lane & 15, quad = lane >> 4;
  f32x4 acc[4][4]; const float dummy[4] = {1.f, 1.f, 1.f, 1.f};
  gemm_tile<false>(HC + (size_t)mt_ * 128 * LDHC, LDHC, W + (size_t)nt_ * 128 * LDPW, LDPW, 512, smem, acc, 0, dummy);
#pragma unroll
  for (int i = 0; i < 4; ++i) {
    const size_t tok = (size_t)mt_ * 128 + wr * 64 + i * 16 + r;
#pragma unroll
    for (int jj = 0; jj < 4; ++jj) {
      const int col = nt_ * 128 + wc * 64 + jj * 16 + quad * 4;
      const u32x2 g = *(const u32x2*)(U + tok * LDU + U_GCONV + col);
      const f32x4 v = acc[i][jj];
      u32x2 wv; wv.x = pk2(v[0] * siluf_(lo2f(g.x)), v[1] * siluf_(hi2f(g.x))); wv.y = pk2(v[2] * siluf_(lo2f(g.y)), v[3] * siluf_(hi2f(g.y)));
      *(u32x2*)(MIX + tok * LDX + MIX_CONV + col) = wv;
    }
  }
}
DI void ssd_item(const P& p, int b, int c, int h, unsigned char* smem) {
  unsigned char* ws = p.ws;
  const bf16_t* XC = (const bf16_t*)(ws + WS_XBCC);
  const float* dtg = (const float*)(ws + WS_DT); const float* acsg = (const float*)(ws + WS_ACS);
  float* YD = (float*)(ws + WS_XBB);
  float* ST = (float*)(ws + WS_STATES);
  const int tid = otid(), lane = tid & 63, w = tid >> 6, r = lane & 15, quad = lane >> 4;
  const int g = h / 6; const size_t tok0 = (size_t)b * 4096 + c * 128;
  bf16_t* R0 = (bf16_t*)smem;
  bf16_t* R1 = (bf16_t*)(smem + 34816);
  float* acs_s = (float*)(smem + 69632);
  float* dt_s = acs_s + 128;
  __syncthreads();
  u32x4 braw[8], xraw[4];
#pragma unroll
  for (int i = 0; i < 8; ++i) {
    const int cidx = tid + 256 * i, row = cidx >> 4, cc = cidx & 15;
    *(u32x4*)(R0 + row * 136 + cc * 8) = *(const u32x4*)(XC + (tok0 + row) * 1280 + g * 128 + cc * 8 + 1024);
  }
#pragma unroll
  for (int i = 0; i < 8; ++i) { const int cidx = tid + 256 * i, lrow = cidx & 127, cc = cidx >> 7; braw[i] = *(const u32x4*)(XC + (tok0 + lrow) * 1280 + 768 + g * 128 + cc * 8); }
#pragma unroll
  for (int i = 0; i < 4; ++i) { const int cidx = tid + 256 * i, lrow = cidx & 127, cc = cidx >> 7; xraw[i] = *(const u32x4*)(XC + (tok0 + lrow) * 1280 + h * 64 + cc * 8); }
#pragma unroll
  for (int i = 0; i < 8; ++i) { const int cidx = tid + 256 * i, lrow = cidx & 127, cc = cidx >> 7; *(u32x4*)(R1 + lrow * 136 + cc * 8) = braw[i]; }
  if (tid < 128) { acs_s[tid] = acsg[(tok0 + tid) * 12 + h]; dt_s[tid] = dtg[(tok0 + tid) * 12 + h]; }
  __syncthreads();
  {
    f32x4 acc[2][8];
#pragma unroll
    for (int i = 0; i < 2; ++i)
#pragma unroll
      for (int j = 0; j < 8; ++j) acc[i][j] = (f32x4){0.f, 0.f, 0.f, 0.f};
#pragma unroll
    for (int ks = 0; ks < 4; ++ks) {
      bf16x8 cf[2];
#pragma unroll
      for (int i = 0; i < 2; ++i) cf[i] = *(const bf16x8*)(R0 + (32 * w + i * 16 + r) * 136 + ks * 32 + quad * 8);
#pragma unroll
      for (int j = 0; j < 8; ++j) {
        const bf16x8 bfr = *(const bf16x8*)(R1 + (j * 16 + r) * 136 + ks * 32 + quad * 8);
        acc[0][j] = mfma16(bfr, cf[0], acc[0][j]); acc[1][j] = mfma16(bfr, cf[1], acc[1][j]);
      }
    }
    __syncthreads();
#pragma unroll
    for (int i = 0; i < 2; ++i) {
      const int lrow = 32 * w + i * 16 + r; const float al = acs_s[lrow];
#pragma unroll
      for (int j = 0; j < 8; ++j) {
        const int s = j * 16 + quad * 4; float mv[4];
#pragma unroll
        for (int t = 0; t < 4; ++t) mv[t] = (s + t <= lrow) ? acc[i][j][t] * __expf(al - acs_s[s + t]) : 0.f;
        u32x2 wv; wv.x = pk2(mv[0], mv[1]); wv.y = pk2(mv[2], mv[3]);
        *(u32x2*)(R0 + lrow * 136 + s) = wv;
      }
    }
  }
  {
    const float alast = acs_s[127];
#pragma unroll
    for (int i = 0; i < 4; ++i) {
      const int cidx = tid + 256 * i, lrow = cidx & 127, cc = cidx >> 7;
      float f[8]; unpack8(xraw[i], f);
      const float d1 = dt_s[lrow], d2 = d1 * __expf(alast - acs_s[lrow]);
#pragma unroll
      for (int e = 0; e < 8; ++e) { R1[(cc * 8 + e) * 136 + lrow] = f2bf(f[e] * d1); R1[(64 + cc * 8 + e) * 136 + lrow] = f2bf(f[e] * d2); }
    }
  }
  __syncthreads();
  {
    f32x4 acc[2][4];
#pragma unroll
    for (int i = 0; i < 2; ++i)
#pragma unroll
      for (int j = 0; j < 4; ++j) acc[i][j] = (f32x4){0.f, 0.f, 0.f, 0.f};
#pragma unroll
    for (int ks = 0; ks < 4; ++ks) {
      bf16x8 mf[2];
#pragma unroll
      for (int i = 0; i < 2; ++i) mf[i] = *(const bf16x8*)(R0 + (32 * w + i * 16 + r) * 136 + ks * 32 + quad * 8);
#pragma unroll
      for (int j = 0; j < 4; ++j) {
        const bf16x8 xf = *(const bf16x8*)(R1 + (j * 16 + r) * 136 + ks * 32 + quad * 8);
        acc[0][j] = mfma16(xf, mf[0], acc[0][j]); acc[1][j] = mfma16(xf, mf[1], acc[1][j]);
      }
    }
#pragma unroll
    for (int i = 0; i < 2; ++i)
#pragma unroll
      for (int j = 0; j < 4; ++j) *(f32x4*)(YD + (tok0 + 32 * w + i * 16 + r) * 768 + h * 64 + j * 16 + quad * 4) = acc[i][j];
  }
  __syncthreads();
#pragma unroll
  for (int i = 0; i < 8; ++i) {
    const int cidx = tid + 256 * i, lrow = cidx & 127, cc = cidx >> 7;
    const bf16x8 v = __builtin_bit_cast(bf16x8, braw[i]);
#pragma unroll
    for (int e = 0; e < 8; ++e) R0[(cc * 8 + e) * 136 + lrow] = (bf16_t)v[e];
  }
  __syncthreads();
  {
    f32x4 acc[8];
#pragma unroll
    for (int j = 0; j < 8; ++j) acc[j] = (f32x4){0.f, 0.f, 0.f, 0.f};
#pragma unroll
    for (int ks = 0; ks < 4; ++ks) {
      const bf16x8 xf = *(const bf16x8*)(R1 + (64 + 16 * w + r) * 136 + ks * 32 + quad * 8);
#pragma unroll
      for (int j = 0; j < 8; ++j) {
        const bf16x8 bfr = *(const bf16x8*)(R0 + (j * 16 + r) * 136 + ks * 32 + quad * 8);
        acc[j] = mfma16(bfr, xf, acc[j]);
      }
    }
    float* dst = ST + ((((size_t)b * 32 + c) * 12 + h) * 64 + 16 * w + r) * 128;
#pragma unroll
    for (int j = 0; j < 8; ++j) *(f32x4*)(dst + j * 16 + quad * 4) = acc[j];
  }
}
DI void scan_item(const P& p, int it) {
  unsigned char* ws = p.ws;
  const float* ST = (const float*)(ws + WS_STATES); const float* acsg = (const float*)(ws + WS_ACS);
  bf16_t* PV = (bf16_t*)(ws + WS_QRAW);
  const int gi = it * 256 + otid(), n4 = gi & 31, pp = (gi >> 5) & 63, bh = gi >> 11, h = bh % 12, b = bh / 12;
  f32x4 st = (f32x4){0.f, 0.f, 0.f, 0.f};
  const size_t off0 = (((size_t)b * 32 * 12 + h) * 64 + pp) * 128 + n4 * 4;
  const float* ap = acsg + ((size_t)b * 4096 + 127) * 12 + h;
#pragma unroll 1
  for (int c0 = 0; c0 < 32; c0 += 16) {
    f32x4 sv[16]; float dc[16];
#pragma unroll
    for (int k = 0; k < 16; ++k) { sv[k] = *(const f32x4*)(ST + off0 + (size_t)(c0 + k) * (12 * 64 * 128)); dc[k] = ap[(size_t)(c0 + k) * 128 * 12]; }
#pragma unroll
    for (int k = 0; k < 16; ++k) {
      u32x2 wv; wv.x = pk2(st[0], st[1]); wv.y = pk2(st[2], st[3]);
      *(u32x2*)(PV + off0 + (size_t)(c0 + k) * (12 * 64 * 128)) = wv;
      st = st * __expf(dc[k]) + sv[k];
    }
  }
}

DI void combine_item(const P& p, int sidx) {
  unsigned char* ws = p.ws;
  const bf16_t* U = (const bf16_t*)(ws + WS_U);
  const bf16_t* PO = (const bf16_t*)(ws + WS_PO);
  const float* PML = (const float*)(ws + WS_PML);
  bf16_t* MIX = (bf16_t*)(ws + WS_XBA);
  const int tid = otid(), row = tid >> 1, half = tid & 1;
  const int bh = sidx >> 4, qb = 16 + (sidx & 15), b = bh / 6, h = bh % 6;
  const size_t tok = (size_t)b * 4096 + qb * 128 + row;
  const size_t s0 = (size_t)sidx * 2, s1 = s0 + 1;
  const float m0 = PML[(s0 * 128 + row) * 2], l0 = PML[(s0 * 128 + row) * 2 + 1], m1 = PML[(s1 * 128 + row) * 2], l1 = PML[(s1 * 128 + row) * 2 + 1];
  const float mm = fmaxf(m0, m1);
  float w0 = l0 * __builtin_amdgcn_exp2f(m0 - mm), w1 = l1 * __builtin_amdgcn_exp2f(m1 - mm);
  const float inv = 1.f / (w0 + w1); w0 *= inv; w1 *= inv;
  const bf16_t* p0 = PO + (s0 * 128 + row) * 128 + half * 64; const bf16_t* p1 = PO + (s1 * 128 + row) * 128 + half * 64;
  const bf16_t* gp = U + tok * LDU + U_GMLA + h * 128 + half * 64;
  bf16_t* mp = MIX + tok * LDX + MIX_MLA + h * 128 + half * 64;
  u32x4 a[8], c[8], g[8];
#pragma unroll
  for (int i = 0; i < 8; ++i) { a[i] = *(const u32x4*)(p0 + i * 8); c[i] = *(const u32x4*)(p1 + i * 8); g[i] = *(const u32x4*)(gp + i * 8); }
#pragma unroll
  for (int i = 0; i < 8; ++i) {
    float fa[8], fc[8], fg[8]; unpack8(a[i], fa); unpack8(c[i], fc); unpack8(g[i], fg);
    float o[8];
#pragma unroll
    for (int e = 0; e < 8; ++e) o[e] = (fa[e] * w0 + fc[e] * w1) * siluf_(fg[e]);
    u32x4 wv; wv.x = pk2(o[0], o[1]); wv.y = pk2(o[2], o[3]); wv.z = pk2(o[4], o[5]); wv.w = pk2(o[6], o[7]);
    *(u32x4*)(mp + i * 8) = wv;
  }
}

DI void yoff_item(const P& p, int L, int b, int c, int h, unsigned char* smem) {
  unsigned char* ws = p.ws;
  const bf16_t* U = (const bf16_t*)(ws + WS_U);
  const bf16_t* XC = (const bf16_t*)(ws + WS_XBCC);
  const bf16_t* PV = (const bf16_t*)(ws + WS_QRAW);
  const float* acsg = (const float*)(ws + WS_ACS);
  const float* YD = (const float*)(ws + WS_XBB);
  bf16_t* MIX = (bf16_t*)(ws + WS_XBA);
  float* sss = (float*)(ws + WS_SSS);
  const int tid = otid(), lane = tid & 63, w = tid >> 6, r = lane & 15, quad = lane >> 4;
  const int g = h / 6; const size_t tok0 = (size_t)b * 4096 + c * 128;
  bf16_t* R0 = (bf16_t*)smem;
  bf16_t* R1 = (bf16_t*)(smem + 34816);
  float* acs_s = (float*)(smem + 69632);
  f32x4 pyd[2][4]; u32x2 pxv[2][4], pzv[2][4];
#pragma unroll
  for (int i = 0; i < 2; ++i)
#pragma unroll
    for (int j = 0; j < 4; ++j) {
      const size_t tok = tok0 + 32 * w + i * 16 + r; const int col = h * 64 + j * 16 + quad * 4;
      pyd[i][j] = *(const f32x4*)(YD + tok * 768 + col);
      pxv[i][j] = *(const u32x2*)(XC + tok * 1280 + col);
      pzv[i][j] = *(const u32x2*)(U + tok * LDU + (col < Z_HEAD ? U_Z + col : U_ZT + (col - Z_HEAD)));
    }
  __syncthreads();
#pragma unroll
  for (int i = 0; i < 8; ++i) {
    const int cidx = tid + 256 * i, row = cidx >> 4, cc = cidx & 15;
    *(u32x4*)(R0 + row * 136 + cc * 8) = *(const u32x4*)(XC + (tok0 + row) * 1280 + 1024 + g * 128 + cc * 8);
  }
#pragma unroll
  for (int i = 0; i < 4; ++i) {
    const int cidx = tid + 256 * i, row = cidx >> 4, cc = cidx & 15;
    *(u32x4*)(R1 + row * 136 + cc * 8) = *(const u32x4*)(PV + ((((size_t)b * 32 + c) * 12 + h) * 64 + row) * 128 + cc * 8);
  }
  if (tid < 128) acs_s[tid] = acsg[(tok0 + tid) * 12 + h];
  __syncthreads();
  f32x4 acc[2][4];
#pragma unroll
  for (int i = 0; i < 2; ++i)
#pragma unroll
    for (int j = 0; j < 4; ++j) acc[i][j] = (f32x4){0.f, 0.f, 0.f, 0.f};
#pragma unroll
  for (int ks = 0; ks < 4; ++ks) {
    bf16x8 cf[2];
#pragma unroll
    for (int i = 0; i < 2; ++i) cf[i] = *(const bf16x8*)(R0 + (32 * w + i * 16 + r) * 136 + ks * 32 + quad * 8);
#pragma unroll
    for (int j = 0; j < 4; ++j) {
      const bf16x8 pf = *(const bf16x8*)(R1 + (j * 16 + r) * 136 + ks * 32 + quad * 8);
      acc[0][j] = mfma16(pf, cf[0], acc[0][j]); acc[1][j] = mfma16(pf, cf[1], acc[1][j]);
    }
  }
  const float Dh = p.ssd_D[L * 12 + h];
#pragma unroll
  for (int i = 0; i < 2; ++i) {
    const int lrow = 32 * w + i * 16 + r; const size_t tok = tok0 + lrow; const float e = __expf(acs_s[lrow]);
    float ss = 0.f;
#pragma unroll
    for (int j = 0; j < 4; ++j) {
      const int col = h * 64 + j * 16 + quad * 4;
      const f32x4 yd = pyd[i][j]; const u32x2 xv = pxv[i][j]; const u32x2 zv = pzv[i][j];
      const float y0 = acc[i][j][0] * e + yd[0] + Dh * lo2f(xv.x), y1 = acc[i][j][1] * e + yd[1] + Dh * hi2f(xv.x);
      const float y2 = acc[i][j][2] * e + yd[2] + Dh * lo2f(xv.y), y3 = acc[i][j][3] * e + yd[3] + Dh * hi2f(xv.y);
      const float g0 = y0 * siluf_(lo2f(zv.x)), g1 = y1 * siluf_(hi2f(zv.x)), g2 = y2 * siluf_(lo2f(zv.y)), g3 = y3 * siluf_(hi2f(zv.y));
      ss += g0 * g0 + g1 * g1 + g2 * g2 + g3 * g3;
      u32x2 wv; wv.x = pk2(g0, g1); wv.y = pk2(g2, g3);
      *(u32x2*)(MIX + tok * LDX + MIX_SSD + col) = wv;
    }
    ss += __shfl_xor(ss, 16); ss += __shfl_xor(ss, 32);
    if (quad == 0) atomicAdd(sss + tok, ss);
  }
}

DI void phase6(const P& p, int L, unsigned char* smem, int rep) {
  unsigned char* ws = p.ws;
  const bf16_t* MIX = (const bf16_t*)(ws + WS_XBA);
  const bf16_t* W = (const bf16_t*)(ws + WS_WOUT + L * SZ_WOUT);
  const float* sss = (const float*)(ws + WS_SSS);
  float* ssx = (float*)(ws + WS_SSX);
  bf16_t* XB = (bf16_t*)(ws + WS_XBB);
  const float* xin = (L == 0) ? p.x : (const float*)p.out;
  const int tid = otid(), lane = tid & 63, wave = tid >> 6, wr = wave >> 1, wc = wave & 1, r = lane & 15, quad = lane >> 4;
  constexpr int NTILE = 64 * 16;
  for (int t = blockIdx.x; t < NTILE; t += gridDim.x) {
    const int mt_ = t >> 4, nt_ = t & 15;
    float rsc[4];
#pragma unroll
    for (int i = 0; i < 4; ++i) rsc[i] = rsqrtf(sss[mt_ * 128 + wr * 64 + i * 16 + r] * (1.f / 768.f) + 1e-6f);
    f32x4 acc[4][4], xr[4][4];
#pragma unroll
    for (int i = 0; i < 4; ++i)
#pragma unroll
      for (int j = 0; j < 4; ++j) xr[i][j] = __builtin_nontemporal_load((const f32x4*)(xin + ((size_t)mt_ * 128 + wr * 64 + i * 16 + r) * 2048 + nt_ * 128 + wc * 64 + j * 16 + quad * 4));
    gemm_tile<true>(MIX + (size_t)mt_ * 128 * LDX, LDX, W + (size_t)nt_ * 128 * LDX, LDX, 2048, smem, acc, 12, rsc);
#pragma unroll
    for (int i = 0; i < 4; ++i) {
      const size_t row = (size_t)mt_ * 128 + wr * 64 + i * 16 + r; float ss = 0.f;
#pragma unroll
      for (int j = 0; j < 4; ++j) {
        const int col = nt_ * 128 + wc * 64 + j * 16 + quad * 4;
        f32x4 v = xr[i][j] + acc[i][j];
        if (L == 1) __builtin_nontemporal_store(v, (f32x4*)(p.out + row * 2048 + col)); else *(f32x4*)(p.out + row * 2048 + col) = v;
        if (L == 0) {
          ss += v[0] * v[0] + v[1] * v[1] + v[2] * v[2] + v[3] * v[3];
          u32x2 wv; wv.x = pk2(v[0], v[1]); wv.y = pk2(v[2], v[3]);
          *(u32x2*)(XB + row * LDX + col) = wv;
        }
      }
      if (L == 0) { ss += __shfl_xor(ss, 16); ss += __shfl_xor(ss, 32); if (quad == 0 && rep == 0) atomicAdd(ssx + row, ss); }
    }
  }
}
template <int PH>
DI void run_phase(const P& p, unsigned char* smem, int* s_item, int rep) {
  int* ctr = (int*)(p.ws + WS_CTRL);
  if (PH == 0) {
    phase0(p, smem);
  } else {
    constexpr int L = (PH - 1) / 6, sub = (PH - 1) % 6;
    if (sub == 0) {
      phase1(p, L, smem);
    } else if (sub == 1) {
      constexpr int N_T40 = 64, N_DT = 64, N_CV = 512, N_KV = 768, N_Q = 576, N_SC = 512, N_ALL = N_T40 + N_KV + N_Q + N_CV + N_SC + N_DT;
      if (gridDim.x == 512) {
        const int b = blockIdx.x;
        if (b < 64) inproj_tile(p, L, b, 40, smem);
        else if (b < 128) dt_item(p, L, b - 64, smem);
        conv_item(p, L, b, smem);
        if (b < 128) kv_item(p, L, b / 12, b % 12, smem);
        else if (b < 384) { const int k0 = 128 + 2 * (b - 128); kv_item(p, L, k0 / 12, k0 % 12, smem); kv_item(p, L, (k0 + 1) / 12, (k0 + 1) % 12, smem); }
        else { const int k0 = 640 + (b - 384); kv_item(p, L, k0 / 12, k0 % 12, smem); }
        if (b < 64) { const int q0 = 512 + b; q_item(p, L, q0 / 9, q0 % 9, smem); }
        else if (b >= 128 && b < 384) { const int q0 = b - 128; q_item(p, L, q0 / 9, q0 % 9, smem); }
        else if (b >= 384) { const int q0 = 256 + 2 * (b - 384); q_item(p, L, q0 / 9, q0 % 9, smem); q_item(p, L, (q0 + 1) / 9, (q0 + 1) % 9, smem); }
        ssdconv_item(p, L, b);
      } else
      for (;;) {
        __syncthreads();
        if (threadIdx.x == 0) *s_item = atomicAdd(ctr + PH + 16 * rep, 1);
        __syncthreads();
        int it = *s_item;
        if (it >= N_ALL) break;
        if (it < N_T40) inproj_tile(p, L, it, 40, smem);
        else if ((it -= N_T40) < N_DT) dt_item(p, L, it, smem);
        else if ((it -= N_DT) < N_CV) conv_item(p, L, it, smem);
        else if ((it -= N_CV) < N_KV) kv_item(p, L, it / 12, it % 12, smem);
        else if ((it -= N_KV) < N_Q) q_item(p, L, it / 9, it % 9, smem);
        else ssdconv_item(p, L, it - N_Q);
      }
    } else if (sub == 2) {
      constexpr int N_AT = 576, N_SS = 768, N_PW = 256, N_ALL = N_AT + N_SS + N_PW;
      for (bool first = true;; first = false) {
        __syncthreads();
        if (threadIdx.x == 0) *s_item = first ? (int)blockIdx.x : (int)gridDim.x + atomicAdd(ctr + PH + 16 * rep, 1);
        __syncthreads();
        int it = *s_item;
        if (it >= N_ALL) break;
        if (it < N_AT) {
          const int xq = it & 7, jq = it >> 3, g3 = jq / 3, r3 = jq % 3;
          const int slot = (r3 < 2) ? 2 * g3 + r3 : 2 * g3 + (xq & 1), bh = (r3 < 2) ? xq : 8 + (xq >> 1); int qb, part;
          if (slot < 40) { const int g = slot / 5, rr = slot % 5, q2 = 15 - g;
            if (rr == 2) { qb = q2; part = -1; } else if (rr < 2) { qb = 2 * q2 + 1; part = rr; } else { qb = 2 * q2; part = rr - 3; } }
          else { qb = 47 - slot; part = -1; }
          const int nt = 2 * qb + 2;
          const int t_lo = (part == 1) ? qb + 1 : 0, t_hi = (part == 0) ? qb + 1 : nt;
          attn_item(p, L, bh / 6, bh % 6, qb, t_lo, t_hi, part, smem);
        }
        else if ((it -= N_AT) < N_SS) { const int h = it % 12, bc = it / 12; ssd_item(p, bc >> 5, bc & 31, h, smem); }
        else { it -= N_SS; pw_item(p, L, it >> 2, it & 3, smem); }
      }
    } else if (sub == 3) {
      for (int it = blockIdx.x; it < 384; it += gridDim.x) {
        if (it < 64 && threadIdx.x < 128) ((float*)(p.ws + WS_SSX))[it * 128 + threadIdx.x] = 0.f;
        if (it < 192) scan_item(p, it); else combine_item(p, it - 192);
      }
    } else if (sub == 4) {
      for (int it = blockIdx.x; it < 768; it += gridDim.x) { const int h = it % 12, bc = it / 12; yoff_item(p, L, bc >> 5, bc & 31, h, smem); }
    } else {
      phase6(p, L, smem, rep);
    }
  }
}
#define PROBE_REP_PH -1
#define RUN_PH(k) if (p.phase_lo <= (k) && (k) <= p.phase_hi) { for (int rep = 0; rep < ((k) == PROBE_REP_PH ? 2 : 1); ++rep) { run_phase<k>(p, smem, (int*)&sh_ctl[1], rep); \
    if (p.coop && ((k) < p.phase_hi || (rep == 0 && (k) == PROBE_REP_PH))) xcd_barrier(xb); } }
__global__ void __launch_bounds__(256, 2) mega(P p) {
  extern __shared__ __attribute__((aligned(16))) unsigned char smem[];
  __shared__ uint4 sh_ctl[2];
  cg::grid_group grid = cg::this_grid();
  if (threadIdx.x == 0) { sh_ctl[0] = make_uint4(0u, 0u, 0u, 0u); sh_ctl[1] = make_uint4(0u, 0u, 0u, 0u); }
  __syncthreads();
  XcdBarrier xb = xcd_barrier_post((unsigned*)(p.ws + WS_BAR), (volatile LAS unsigned*)&sh_ctl[0]);
  if (p.pad != 0) grid.sync();
  RUN_PH(0) RUN_PH(1) RUN_PH(2) RUN_PH(3) RUN_PH(4) RUN_PH(5) RUN_PH(6) RUN_PH(7) RUN_PH(8) RUN_PH(9) RUN_PH(10) RUN_PH(11) RUN_PH(12)
}

extern "C" void kernel_launch(void* const* d_in, const int* in_sizes, int n_in, void* d_out, int out_size, void* d_ws, size_t ws_size, hipStream_t stream) {
  static int grid_blocks = 0;
  if (grid_blocks == 0) {
    if (ws_size < WS_END) { fprintf(stderr, "kernel_launch: workspace too small: %zu < %zu\n", ws_size, (size_t)WS_END); grid_blocks = -1; return; }
    int dev = 0, cus = 0, per_cu = 0;
    hipGetDevice(&dev);
    hipDeviceGetAttribute(&cus, hipDeviceAttributeMultiprocessorCount, dev);
    hipFuncSetAttribute((const void*)mega, hipFuncAttributeMaxDynamicSharedMemorySize, SMEM_BYTES);
    hipOccupancyMaxActiveBlocksPerMultiprocessor(&per_cu, (const void*)mega, NT, SMEM_BYTES);
    if (per_cu < 1) per_cu = 1;
    if (per_cu > 2) per_cu = 2;
    grid_blocks = cus * per_cu;
    fprintf(stderr, "kernel_launch: cus %d per_cu %d grid %d ws %zu need %zu\n", cus, per_cu, grid_blocks, ws_size, (size_t)WS_END);
  }
  if (grid_blocks < 0) return;
  P p{};
  const float** f = (const float**)&p;
  for (int i = 0; i < 21; ++i) f[i] = (const float*)d_in[i];
  p.out = (float*)d_out; p.ws = (unsigned char*)d_ws;
  p.phase_lo = 0; p.phase_hi = 12; p.coop = 1; p.pad = 0;
  if (hipMemsetAsync(d_ws, 0, 16384, stream) != hipSuccess) { fprintf(stderr, "kernel_launch: hipMemsetAsync of the control words failed\n"); return; }
  void* args[] = {&p};
  hipError_t e = hipLaunchCooperativeKernel((const void*)mega, dim3(grid_blocks), dim3(NT), args, SMEM_BYTES, stream);
  if (e != hipSuccess) fprintf(stderr, "cooperative launch failed: %s (grid %d)\n", hipGetErrorString(e), grid_blocks);
}
```
